# Optimizing an MI355X kernel written in HIP

```python
import math
import jax, jax.numpy as jnp
from jax import lax
import numpy as np

D_MODEL = 1024
BATCH = 8
SEQ = 8192
DEPTH = 4

D_MIX = D_MODEL
POOL_W = D_MIX // 4
SCONV_W = D_MIX // 4
ATTN_W = D_MIX // 4
CONF_W = D_MIX // 4
POOL_WINDOWS = (2, 4, 8, 16)
N_POOL_GROUPS = len(POOL_WINDOWS)
POOL_GROUP = POOL_W // N_POOL_GROUPS
SCONV_K = 3
N_DIFF_HEADS = 4
DIFF_V_DIM = ATTN_W // N_DIFF_HEADS
DIFF_QK_DIM = DIFF_V_DIM // 2
ROPE_DIM = DIFF_QK_DIM // 4
ROPE_THETA = 500000.0
Q_BLOCK = 128
CONF_K = 31
D_FF = 2816
N_EXPERTS = 8
TOP_K = 2
D_FF_EXPERT = 3584
N_DENSE = (DEPTH + 1) // 2
N_MOE = DEPTH // 2
DN_ALPHA = (2 * DEPTH) ** 0.25
DN_BETA = (8 * DEPTH) ** -0.25
LN_EPS = 1e-5
IN_SIZES = (POOL_W,
            SCONV_W, SCONV_W, SCONV_W,
            ATTN_W, ATTN_W, ATTN_W,
            CONF_W, CONF_W)
IN_COLS = sum(IN_SIZES)

kernel_name = "hybrid_pool_sconv_diffattn_conformer_moe"


def layer_norm(x, g, b):
    xf = x.astype(jnp.float32)
    mu = jnp.mean(xf, axis=-1, keepdims=True)
    xc = xf - mu
    var = jnp.mean(xc * xc, axis=-1, keepdims=True)
    return (xc * lax.rsqrt(var + LN_EPS) * g.astype(jnp.float32) + b.astype(jnp.float32)).astype(x.dtype)


def causal_depthwise_conv(x, w):
    k, c = w.shape
    return lax.conv_general_dilated(
        x, w[:, None, :].astype(x.dtype), window_strides=(1,), padding=[(k - 1, 0)],
        dimension_numbers=('NWC', 'WIO', 'NWC'), feature_group_count=c)


def pool_mixer(h, w_pool, pool_scale):
    b, s, c = h.shape
    hf = h.astype(jnp.float32)
    cs = jnp.cumsum(hf, axis=1)
    tpos = jnp.arange(1, s + 1)
    outs = []
    for gi, w in enumerate(POOL_WINDOWS):
        sl = slice(gi * POOL_GROUP, (gi + 1) * POOL_GROUP)
        csg = cs[..., sl]
        lag = jnp.pad(csg, ((0, 0), (w, 0), (0, 0)))[:, :s]
        cnt = jnp.minimum(tpos, w).astype(jnp.float32)[None, :, None]
        outs.append((csg - lag) / cnt - hf[..., sl])
    d = jnp.stack(outs, axis=2).astype(h.dtype)
    y = jnp.einsum('bsgc,gce->bsge', d, w_pool).reshape(b, s, c)
    return y * pool_scale


def short_conv_mixer(gate_b, gate_c, h, w_conv):
    return gate_b * causal_depthwise_conv(gate_c * h, w_conv)


def rope_tables(positions):
    inv = ROPE_THETA ** (-jnp.arange(0, ROPE_DIM, 2, dtype=jnp.float32) / ROPE_DIM)
    ang = positions.astype(jnp.float32)[..., None] * inv
    return jnp.cos(ang), jnp.sin(ang)


def partial_rope(x, cos, sin):
    half = ROPE_DIM // 2
    xr = x[..., :ROPE_DIM].astype(jnp.float32)
    x1, x2 = xr[..., :half], xr[..., half:]
    c = cos[:, :, None, None, :]
    sn = sin[:, :, None, None, :]
    rot = jnp.concatenate([x1 * c - x2 * sn, x2 * c + x1 * sn], axis=-1)
    return jnp.concatenate([rot.astype(x.dtype), x[..., ROPE_DIM:]], axis=-1)


def diff_attention(q, k, v, lam, lam_init, subln_g):
    b, s = q.shape[:2]
    nb = s // Q_BLOCK
    qt = (q * (DIFF_QK_DIM ** -0.5)).transpose(0, 2, 3, 1, 4)
    kt = k.transpose(0, 2, 3, 1, 4)
    vt = v.transpose(0, 2, 1, 3)
    kpos = jnp.arange(s)

    def block(i):
        q0 = i * Q_BLOCK
        qb = lax.dynamic_slice_in_dim(qt, q0, Q_BLOCK, axis=3)
        sc = jnp.einsum('bhmqd,bhmkd->bhmqk', qb, kt).astype(jnp.float32)
        qpos = q0 + jnp.arange(Q_BLOCK)
        sc = jnp.where(kpos[None, :] <= qpos[:, None], sc, -jnp.inf)
        p = jax.nn.softmax(sc, axis=-1)
        a = p[:, :, 0] - lam * p[:, :, 1]
        return jnp.einsum('bhqk,bhke->bhqe', a.astype(v.dtype), vt)

    o = lax.map(block, jnp.arange(nb))
    o = o.transpose(1, 0, 3, 2, 4).reshape(b, s, N_DIFF_HEADS, DIFF_V_DIM)
    of = o.astype(jnp.float32)
    of = of * lax.rsqrt(jnp.mean(of * of, axis=-1, keepdims=True) + LN_EPS) * subln_g.astype(jnp.float32)
    return (of * (1.0 - lam_init)).reshape(b, s, ATTN_W).astype(v.dtype)


def conformer_conv(a, g, w_dw, ln_g, ln_b):
    u = a * jax.nn.sigmoid(g)
    u = causal_depthwise_conv(u, w_dw)
    u = layer_norm(u, ln_g, ln_b)
    return jax.nn.silu(u)


def hybrid_mixer(x, w_in, w_o, pool_w, pool_scale, sconv_w, lam_params, subln_g,
                 conf_dw, conf_ln_g, conf_ln_b, cos, sin, lam_init):
    b, s, _ = x.shape
    z = x @ w_in
    (p_in, sb, scg, sh, qf, kf, vf, ca, cg) = jnp.split(
        z, np.cumsum(IN_SIZES)[:-1].tolist(), axis=-1)
    y_pool = pool_mixer(p_in, pool_w, pool_scale)
    y_sconv = short_conv_mixer(sb, scg, sh, sconv_w)
    q = partial_rope(qf.reshape(b, s, N_DIFF_HEADS, 2, DIFF_QK_DIM), cos, sin)
    k = partial_rope(kf.reshape(b, s, N_DIFF_HEADS, 2, DIFF_QK_DIM), cos, sin)
    v = vf.reshape(b, s, N_DIFF_HEADS, DIFF_V_DIM)
    lp = lam_params.astype(jnp.float32)
    lam = jnp.exp(jnp.sum(lp[0] * lp[1])) - jnp.exp(jnp.sum(lp[2] * lp[3])) + lam_init
    y_attn = diff_attention(q, k, v, lam, lam_init, subln_g)
    y_conf = conformer_conv(ca, cg, conf_dw, conf_ln_g, conf_ln_b)
    y = jnp.concatenate([y_pool, y_sconv, y_attn, y_conf], axis=-1)
    return y @ w_o


def swiglu(x, wg, wu, wd):
    return (jax.nn.silu(x @ wg) * (x @ wu)) @ wd


def moe_swiglu(x, w_router, wg, wu, wd):
    b, s, d = x.shape
    xt = x.reshape(b * s, d)
    logits = (xt @ w_router).astype(jnp.float32)
    top_v, top_i = lax.top_k(logits, TOP_K)
    top_w = jax.nn.softmax(top_v, axis=-1)
    gates = jnp.sum(jax.nn.one_hot(top_i, N_EXPERTS, dtype=jnp.float32) * top_w[..., None], axis=1)
    out = jnp.zeros_like(xt)
    for e in range(N_EXPERTS):
        out = out + gates[:, e:e + 1].astype(x.dtype) * swiglu(xt, wg[e], wu[e], wd[e])
    return out.reshape(b, s, d)


def setup_inputs(seed: int = 0) -> dict:
    key = jax.random.key(seed)
    ks = jax.random.split(key, 32)
    f32 = jnp.float32
    nrm = lambda k, shape, sc: jax.random.normal(k, shape, f32) * sc
    x = jax.random.normal(ks[0], (BATCH, SEQ, D_MODEL), f32)
    offset = jax.random.randint(ks[1], (BATCH, 1), 0, 4096, dtype=jnp.int32)
    positions = (offset + jnp.arange(SEQ, dtype=jnp.int32)[None, :]).astype(jnp.int32)
    return {
        "x": x,
        "positions": positions,
        "w_in": nrm(ks[2], (DEPTH, D_MODEL, IN_COLS), D_MODEL ** -0.5),
        "w_o": nrm(ks[3], (DEPTH, D_MIX, D_MODEL), DN_BETA * D_MIX ** -0.5),
        "pool_w": nrm(ks[4], (DEPTH, N_POOL_GROUPS, POOL_GROUP, POOL_GROUP), POOL_GROUP ** -0.5),
        "pool_scale": 1.0 + nrm(ks[5], (DEPTH, POOL_W), 0.02),
        "sconv_w": nrm(ks[6], (DEPTH, SCONV_K, SCONV_W), SCONV_K ** -0.5),
        "diff_lambda": nrm(ks[7], (DEPTH, 4, DIFF_QK_DIM), 0.1),
        "diff_subln_g": 1.0 + nrm(ks[8], (DEPTH, DIFF_V_DIM), 0.02),
        "conf_dw": nrm(ks[9], (DEPTH, CONF_K, CONF_W), CONF_K ** -0.5),
        "conf_ln_g": 1.0 + nrm(ks[10], (DEPTH, CONF_W), 0.02),
        "conf_ln_b": nrm(ks[11], (DEPTH, CONF_W), 0.02),
        "ln1_g": 1.0 + nrm(ks[12], (DEPTH, D_MODEL), 0.02),
        "ln1_b": nrm(ks[13], (DEPTH, D_MODEL), 0.02),
        "ln2_g": 1.0 + nrm(ks[14], (DEPTH, D_MODEL), 0.02),
        "ln2_b": nrm(ks[15], (DEPTH, D_MODEL), 0.02),
        "ffn_wg": nrm(ks[16], (N_DENSE, D_MODEL, D_FF), D_MODEL ** -0.5),
        "ffn_wu": nrm(ks[17], (N_DENSE, D_MODEL, D_FF), D_MODEL ** -0.5),
        "ffn_wd": nrm(ks[18], (N_DENSE, D_FF, D_MODEL), DN_BETA * D_FF ** -0.5),
        "router_w": nrm(ks[19], (N_MOE, D_MODEL, N_EXPERTS), D_MODEL ** -0.5),
        "moe_wg": nrm(ks[20], (N_MOE, N_EXPERTS, D_MODEL, D_FF_EXPERT), D_MODEL ** -0.5),
        "moe_wu": nrm(ks[21], (N_MOE, N_EXPERTS, D_MODEL, D_FF_EXPERT), D_MODEL ** -0.5),
        "moe_wd": nrm(ks[22], (N_MOE, N_EXPERTS, D_FF_EXPERT, D_MODEL), DN_BETA * D_FF_EXPERT ** -0.5),
    }


def reference(x, positions, w_in, w_o, pool_w, pool_scale, sconv_w, diff_lambda, diff_subln_g,
              conf_dw, conf_ln_g, conf_ln_b, ln1_g, ln1_b, ln2_g, ln2_b,
              ffn_wg, ffn_wu, ffn_wd, router_w, moe_wg, moe_wu, moe_wd):
    cos, sin = rope_tables(positions)
    for l in range(DEPTH):
        lam_init = 0.8 - 0.6 * math.exp(-0.3 * l)
        y = hybrid_mixer(x, w_in[l], w_o[l], pool_w[l], pool_scale[l], sconv_w[l],
                         diff_lambda[l], diff_subln_g[l], conf_dw[l], conf_ln_g[l], conf_ln_b[l],
                         cos, sin, lam_init)
        x = layer_norm(DN_ALPHA * x + y, ln1_g[l], ln1_b[l])
        j = l // 2
        if l % 2 == 0:
            f = swiglu(x, ffn_wg[j], ffn_wu[j], ffn_wd[j])
        else:
            f = moe_swiglu(x, router_w[j], moe_wg[j], moe_wu[j], moe_wd[j])
        x = layer_norm(DN_ALPHA * x + f, ln2_g[l], ln2_b[l])
    return x
```

```cpp
#include <hip/hip_runtime.h>
#include <hip/hip_bf16.h>
#include <cstdio>
#include <cstdint>
#include <cmath>

#ifndef PG8_ASM_DMA_ALL
#define PG8_ASM_DMA_ALL true
#endif
namespace pg8 {
#define PG8_LAS __attribute__((address_space(3)))
typedef unsigned short bf16_t;
typedef short bf16x8 __attribute__((ext_vector_type(8)));
typedef float f32x4 __attribute__((ext_vector_type(4)));
typedef float f32x2 __attribute__((ext_vector_type(2)));
typedef unsigned u32x4 __attribute__((ext_vector_type(4)));
typedef unsigned u32x2 __attribute__((ext_vector_type(2)));
typedef int v4i_t __attribute__((ext_vector_type(4)));
typedef int v8i_t __attribute__((ext_vector_type(8)));
constexpr int BM = 256, BK = 64, HALF = 128, HTB = HALF * BK * 2, STAGE_BYTES = 8 * HTB, NXCD = 8, WGM = 8;

__host__ __device__ __forceinline__ int lds_byte(int r, int c) { const int st = (r >> 4) * 2 + (c >> 5), rr = r & 15, cc = c & 31, ob = rr * 64 + cc * 2; return st * 1024 + (ob ^ (((ob >> 9) & 1) << 5)); }
__host__ __device__ __forceinline__ void stage_rc(int b, int& R, int& C) { const int st = b / 1024, sb = b % 1024, swz = sb ^ (((sb >> 9) & 1) << 5); R = (st >> 1) * 16 + swz / 64; C = (st & 1) * 32 + (swz % 64) / 2; }
__host__ __device__ __forceinline__ int perm32(int rho) { const int n = rho >> 4, i = rho & 15; return 8 * (i >> 2) + 4 * n + (i & 3); }

struct Unit { int pm, pn, pb; };
struct Gemm { const bf16_t* A; const bf16_t* Bt; int K; };

__device__ __forceinline__ bool static_unit(int nM, int nN, int G, int c, int i, int& pm, int& pn) {
    const int nwg = nM * nN; const long L = (long)i * G + c; if (L >= nwg) return false;
    int wgid = (int)L; { const int q = nwg / NXCD, r = nwg % NXCD, xcd = wgid % NXCD, off = wgid / NXCD; wgid = (xcd < r ? xcd * (q + 1) : r * (q + 1) + (xcd - r) * q) + off; }
    const int nig = WGM * nN, gid = wgid / nig, fm = gid * WGM, gsz = (nM - fm) < WGM ? (nM - fm) : WGM;
    pm = fm + ((wgid % nig) % gsz); pn = (wgid % nig) / gsz; return true;
}
struct StaticOrder {
    static constexpr bool GATHER = false;
    int nM, nN, G, c;
    __device__ __forceinline__ bool next(int i, Unit& u) const { int pm, pn; if (!static_unit(nM, nN, G, c, i, pm, pn)) return false; u.pm = pm; u.pn = pn; u.pb = pn; return true; }
    __device__ __forceinline__ unsigned a_row(int, const Unit& u, int r) const { return (unsigned)(u.pm * BM + r); }
};

struct PanelOrder {
    static constexpr bool GATHER = false;
    int nM, nN, G, c;
    __device__ __forceinline__ bool next(int i, Unit& u) const { const int p = c + (i / nN) * G; if (p >= nM) return false; u.pm = p; u.pn = i % nN; u.pb = u.pn; return true; }
    __device__ __forceinline__ unsigned a_row(int, const Unit& u, int r) const { return (unsigned)(u.pm * BM + r); }
};
__device__ __forceinline__ unsigned cvt_pk_bf16(float lo, float hi) { unsigned r; asm volatile("v_cvt_pk_bf16_f32 %0, %1, %2" : "=v"(r) : "v"(lo), "v"(hi)); return r; }

template <bool ROPE> struct EpiBf {
    static constexpr bool PERM = true;
    bf16_t* O; int ldc; int row_off; const float* cosb; const float* sinb; int rope_q, rope_k; float qscale; float oscale;
    __device__ __forceinline__ void operator()(const f32x4 (&acc)[2][2][4][2], const Unit& u, int wr, int wc, int fr, int fq) const {
        const int row0 = row_off + u.pm * BM + wr * 64 + fr; const int col0 = u.pn * BM + wc * 32 + 8 * fq;
        const int mode = !ROPE ? 0 : (u.pn == rope_q) ? 2 : (u.pn == rope_k) ? 1 : 0;
#pragma unroll
        for (int ai = 0; ai < 2; ++ai)
#pragma unroll
            for (int m = 0; m < 4; ++m) { const int row = row0 + ai * HALF + m * 16; bf16_t* rowp = O + (size_t)row * ldc + col0;
                f32x4 cs = (f32x4){1.f, 1.f, 1.f, 1.f}, sn = (f32x4){0.f, 0.f, 0.f, 0.f};
                if (ROPE && mode != 0 && fq == 0) { cs = *(const f32x4*)(cosb + (size_t)row * 4); sn = *(const f32x4*)(sinb + (size_t)row * 4); }
#pragma unroll
                for (int bj = 0; bj < 2; ++bj) { f32x4 v0 = acc[ai][bj][m][0], v1 = acc[ai][bj][m][1]; if (oscale != 1.f) { v0 = v0 * oscale; v1 = v1 * oscale; }
                    if (ROPE && mode != 0) { const f32x4 r0 = v0 * cs - v1 * sn, r1 = v1 * cs + v0 * sn; v0 = r0; v1 = r1; if (mode == 2) { v0 = v0 * qscale; v1 = v1 * qscale; } }
                    u32x4 w; w.x = cvt_pk_bf16(v0[0], v0[1]); w.y = cvt_pk_bf16(v0[2], v0[3]); w.z = cvt_pk_bf16(v1[0], v1[1]); w.w = cvt_pk_bf16(v1[2], v1[3]);
                    *(u32x4*)(rowp + bj * HALF) = w; } }
    }
};
struct EpiZ {
    static constexpr bool PERM = true;
    bf16_t* O; int ldc; const float* cosb; const float* sinb; float qscale; unsigned char* V8; unsigned char* KT;
    __device__ __forceinline__ void operator()(const f32x4 (&acc)[2][2][4][2], const Unit& u, int wr, int wc, int fr, int fq) const {
        const int row0 = u.pm * BM + wr * 64 + fr;
        const int pn = u.pn;
        if (pn == 6) {
#pragma unroll
            for (int ai = 0; ai < 2; ++ai)
#pragma unroll
                for (int m = 0; m < 4; ++m) { unsigned char* rowp = V8 + (size_t)(row0 + ai * HALF + m * 16) * BM + wc * 32 + 8 * fq;
#pragma unroll
                    for (int bj = 0; bj < 2; ++bj) { const f32x4 v0 = acc[ai][bj][m][0], v1 = acc[ai][bj][m][1]; u32x2 w;
                        w.x = (unsigned)__builtin_amdgcn_cvt_pk_fp8_f32(v0[2], v0[3], __builtin_amdgcn_cvt_pk_fp8_f32(v0[0], v0[1], 0, false), true); w.y = (unsigned)__builtin_amdgcn_cvt_pk_fp8_f32(v1[2], v1[3], __builtin_amdgcn_cvt_pk_fp8_f32(v1[0], v1[1], 0, false), true);
                        *(u32x2*)(rowp + bj * HALF) = w; } }
            return;
        }
        if (pn == 2 || pn == 3 || pn >= 7) {
            const bool glu = pn >= 7; const int col0 = (glu ? 1024 + (pn - 7) * HALF : 512 + (pn - 2) * HALF) + wc * 32 + 8 * fq;
#pragma unroll
            for (int ai = 0; ai < 2; ++ai)
#pragma unroll
                for (int m = 0; m < 4; ++m) { bf16_t* rowp = O + (size_t)(row0 + ai * HALF + m * 16) * ldc + col0; f32x4 h0, h1;
                    const f32x4 g0 = acc[ai][0][m][0], g1 = acc[ai][0][m][1], v0 = acc[ai][1][m][0], v1 = acc[ai][1][m][1];
                    if (glu) {
#pragma unroll
                        for (int j = 0; j < 4; ++j) { h0[j] = v0[j] * __builtin_amdgcn_rcpf(1.0f + __builtin_amdgcn_exp2f(g0[j] * -1.4426950408889634f)); h1[j] = v1[j] * __builtin_amdgcn_rcpf(1.0f + __builtin_amdgcn_exp2f(g1[j] * -1.4426950408889634f)); }
                    } else { h0 = g0 * v0; h1 = g1 * v1; }
                    u32x4 w; w.x = cvt_pk_bf16(h0[0], h0[1]); w.y = cvt_pk_bf16(h0[2], h0[3]); w.z = cvt_pk_bf16(h1[0], h1[1]); w.w = cvt_pk_bf16(h1[2], h1[3]);
                    *(u32x4*)rowp = w; }
            return;
        }
        const int cb = pn < 2 ? pn * BM : (pn - 1) * BM;
        const int col0 = cb + wc * 32 + 8 * fq;
        const int mode = (pn == 4) ? 2 : (pn == 5) ? 1 : 0;
#pragma unroll
        for (int ai = 0; ai < 2; ++ai)
#pragma unroll
            for (int m = 0; m < 4; ++m) { const int row = row0 + ai * HALF + m * 16; bf16_t* rowp = O + (size_t)row * ldc + col0;
                f32x4 cs = (f32x4){1.f, 1.f, 1.f, 1.f}, sn = (f32x4){0.f, 0.f, 0.f, 0.f};
                if (mode != 0 && fq == 0) { cs = *(const f32x4*)(cosb + (size_t)row * 4); sn = *(const f32x4*)(sinb + (size_t)row * 4); }
#pragma unroll
                for (int bj = 0; bj < 2; ++bj) { f32x4 v0 = acc[ai][bj][m][0], v1 = acc[ai][bj][m][1];
                    if (mode != 0) { const f32x4 r0 = v0 * cs - v1 * sn, r1 = v1 * cs + v0 * sn; v0 = r0; v1 = r1; if (mode == 2) { v0 = v0 * qscale; v1 = v1 * qscale; } }
                    u32x4 w; w.x = cvt_pk_bf16(v0[0], v0[1]); w.y = cvt_pk_bf16(v0[2], v0[3]); w.z = cvt_pk_bf16(v1[0], v1[1]); w.w = cvt_pk_bf16(v1[2], v1[3]);
                    if (mode == 1) {
                        const int b_ = row >> 13, s_ = row & 8191, tl_ = s_ >> 6, ky_ = s_ & 63;
                        *(u32x4*)(KT + ((((size_t)((b_ * 4 + 2 * bj + (wc >> 1)) * 2 + (wc & 1)) * 128 + tl_) * 64 + ky_) * 64 + ((fq ^ ((ky_ >> 2) & 3)) * 16))) = w;
                    } else *(u32x4*)(rowp + bj * HALF) = w; } }
    }
};
struct EpiRes {
    static constexpr bool PERM = true;
    bf16_t* X; int ldc; float alpha; float ascale;
    __device__ __forceinline__ void operator()(const f32x4 (&acc)[2][2][4][2], const Unit& u, int wr, int wc, int fr, int fq) const {
        const int row0 = u.pm * BM + wr * 64 + fr, col0 = u.pn * BM + wc * 32 + 8 * fq;
#pragma unroll
        for (int ai = 0; ai < 2; ++ai)
#pragma unroll
            for (int m = 0; m < 4; ++m) { bf16_t* rowp = X + (size_t)(row0 + ai * HALF + m * 16) * ldc + col0;
                u32x4 rv[2];
#pragma unroll
                for (int bj = 0; bj < 2; ++bj) rv[bj] = *(const u32x4*)(rowp + bj * HALF);
#pragma unroll
                for (int bj = 0; bj < 2; ++bj) { const f32x4 a0 = acc[ai][bj][m][0], a1 = acc[ai][bj][m][1]; const u32x4 r = rv[bj]; u32x4 w;
                    w.x = cvt_pk_bf16(alpha * __builtin_bit_cast(float, r.x << 16) + a0[0] * ascale, alpha * __builtin_bit_cast(float, r.x & 0xffff0000u) + a0[1] * ascale);
                    w.y = cvt_pk_bf16(alpha * __builtin_bit_cast(float, r.y << 16) + a0[2] * ascale, alpha * __builtin_bit_cast(float, r.y & 0xffff0000u) + a0[3] * ascale);
                    w.z = cvt_pk_bf16(alpha * __builtin_bit_cast(float, r.z << 16) + a1[0] * ascale, alpha * __builtin_bit_cast(float, r.z & 0xffff0000u) + a1[1] * ascale);
                    w.w = cvt_pk_bf16(alpha * __builtin_bit_cast(float, r.w << 16) + a1[2] * ascale, alpha * __builtin_bit_cast(float, r.w & 0xffff0000u) + a1[3] * ascale);
                    *(u32x4*)(rowp + bj * HALF) = w; } }
    }
};
struct EpiResLN {
    static constexpr bool PERM = true;
    bf16_t* X; int ldc; float alpha, ascale; const float* gam; const float* bet; unsigned long long* xbuf; unsigned* cnt; unsigned want; unsigned* tmo; PG8_LAS unsigned char* tab;
    __device__ __forceinline__ void operator()(f32x4 (&acc)[2][2][4][2], const Unit& u, int wr, int wc, int fr, int fq) const {
        const int wid = wr * 4 + wc, lane = fq * 16 + fr;
        PG8_LAS f32x2* P = (PG8_LAS f32x2*)tab;
        PG8_LAS f32x2* S = (PG8_LAS f32x2*)(tab + 8192);
        PG8_LAS unsigned* flag = (PG8_LAS unsigned*)(tab + 8192 + 2048);
        const int row0 = u.pm * BM + wr * 64 + fr, col0 = u.pn * BM + wc * 32 + 8 * fq;
#pragma unroll
        for (int ai = 0; ai < 2; ++ai)
#pragma unroll
            for (int m = 0; m < 4; ++m) { const bf16_t* rowp = X + (size_t)(row0 + ai * HALF + m * 16) * ldc + col0;
                u32x4 rv[2];
#pragma unroll
                for (int bj = 0; bj < 2; ++bj) rv[bj] = *(const u32x4*)(rowp + bj * HALF);
#pragma unroll
                for (int bj = 0; bj < 2; ++bj) { const u32x4 r = rv[bj]; f32x4 a0 = acc[ai][bj][m][0], a1 = acc[ai][bj][m][1];
                    a0[0] = alpha * __builtin_bit_cast(float, r.x << 16) + a0[0] * ascale; a0[1] = alpha * __builtin_bit_cast(float, r.x & 0xffff0000u) + a0[1] * ascale;
                    a0[2] = alpha * __builtin_bit_cast(float, r.y << 16) + a0[2] * ascale; a0[3] = alpha * __builtin_bit_cast(float, r.y & 0xffff0000u) + a0[3] * ascale;
                    a1[0] = alpha * __builtin_bit_cast(float, r.z << 16) + a1[0] * ascale; a1[1] = alpha * __builtin_bit_cast(float, r.z & 0xffff0000u) + a1[1] * ascale;
                    a1[2] = alpha * __builtin_bit_cast(float, r.w << 16) + a1[2] * ascale; a1[3] = alpha * __builtin_bit_cast(float, r.w & 0xffff0000u) + a1[3] * ascale;
                    acc[ai][bj][m][0] = a0; acc[ai][bj][m][1] = a1; } }
#pragma unroll
        for (int ai = 0; ai < 2; ++ai)
#pragma unroll
            for (int m = 0; m < 4; ++m) {
                float s = 0.f;
#pragma unroll
                for (int bj = 0; bj < 2; ++bj)
#pragma unroll
                    for (int n = 0; n < 2; ++n) { const f32x4 x = acc[ai][bj][m][n]; s += (x[0] + x[1]) + (x[2] + x[3]); }
                s += __shfl_xor(s, 16); s += __shfl_xor(s, 32);
                const float mw = s * (1.0f / 64.0f); float q = 0.f;
#pragma unroll
                for (int bj = 0; bj < 2; ++bj)
#pragma unroll
                    for (int n = 0; n < 2; ++n) { const f32x4 d = acc[ai][bj][m][n] - mw; q += (d[0] * d[0] + d[1] * d[1]) + (d[2] * d[2] + d[3] * d[3]); }
                q += __shfl_xor(q, 16); q += __shfl_xor(q, 32);
                if (fq == 0) P[(ai * HALF + wr * 64 + m * 16 + fr) * 4 + wc] = (f32x2){mw, q};
            }
        asm volatile("s_waitcnt lgkmcnt(0)" ::: "memory"); __builtin_amdgcn_s_barrier(); asm volatile("" ::: "memory");
        const int row = wid * 32 + (lane & 31);
        if (lane < 32) {
            const f32x2 a = P[row * 4 + 0], b = P[row * 4 + 1], c = P[row * 4 + 2], d = P[row * 4 + 3];
            const float mt = (a.x + b.x + c.x + d.x) * 0.25f;
            const float da = a.x - mt, db = b.x - mt, dc = c.x - mt, dd = d.x - mt;
            const float m2 = (a.y + b.y) + (c.y + d.y) + 64.0f * ((da * da + db * db) + (dc * dc + dd * dd));
            unsigned long long* slot = xbuf + ((size_t)(u.pm * BM + row) * 4 + u.pn);
            __hip_atomic_store(slot, ((unsigned long long)__builtin_bit_cast(unsigned, m2) << 32) | __builtin_bit_cast(unsigned, mt), __ATOMIC_RELAXED, __HIP_MEMORY_SCOPE_AGENT);
        }
        asm volatile("s_waitcnt vmcnt(0)" ::: "memory");
        if (lane == 0) __hip_atomic_fetch_add(cnt + 16 * u.pm, 1u, __ATOMIC_RELAXED, __HIP_MEMORY_SCOPE_AGENT);
        if (wid == 0) {
            unsigned sp = 0u, dead = 0u;
            while ((unsigned)__builtin_amdgcn_readfirstlane((int)__hip_atomic_load(cnt + 16 * u.pm, __ATOMIC_RELAXED, __HIP_MEMORY_SCOPE_AGENT)) < want) {
                __builtin_amdgcn_s_sleep(2);
                if (++sp > (1u << 20)) { dead = 1u; if (lane == 0) __hip_atomic_store(tmo, 1u, __ATOMIC_RELAXED, __HIP_MEMORY_SCOPE_AGENT); break; } }
            __builtin_amdgcn_fence(__ATOMIC_ACQUIRE, "agent");
            if (lane == 0) flag[0] = dead;
        }
        asm volatile("s_waitcnt vmcnt(0) lgkmcnt(0)" ::: "memory"); __builtin_amdgcn_s_barrier(); asm volatile("" ::: "memory");
        if (lane < 32) {
            const unsigned long long* slot = xbuf + (size_t)(u.pm * BM + row) * 4; float mt[4], m2[4]; float ms = 0.f;
#pragma unroll
            for (int t = 0; t < 4; ++t) { const unsigned long long w = __hip_atomic_load(slot + t, __ATOMIC_RELAXED, __HIP_MEMORY_SCOPE_AGENT); mt[t] = __builtin_bit_cast(float, (unsigned)w); m2[t] = __builtin_bit_cast(float, (unsigned)(w >> 32)); ms += mt[t]; }
            const float mean = ms * 0.25f; float q = 0.f;
#pragma unroll
            for (int t = 0; t < 4; ++t) { const float dm = mt[t] - mean; q += m2[t] + 256.0f * dm * dm; }
            S[row] = (f32x2){mean, 1.0f / sqrtf(q * (1.0f / 1024.0f) + 1e-5f)};
        }
        asm volatile("s_waitcnt lgkmcnt(0)" ::: "memory"); __builtin_amdgcn_s_barrier(); asm volatile("" ::: "memory");
#pragma unroll
        for (int bj = 0; bj < 2; ++bj) { const f32x4 g0 = *(const f32x4*)(gam + col0 + bj * HALF), g1 = *(const f32x4*)(gam + col0 + bj * HALF + 4), b0 = *(const f32x4*)(bet + col0 + bj * HALF), b1 = *(const f32x4*)(bet + col0 + bj * HALF + 4);
#pragma unroll
            for (int ai = 0; ai < 2; ++ai)
#pragma unroll
                for (int m = 0; m < 4; ++m) { const f32x2 sr = S[ai * HALF + wr * 64 + m * 16 + fr]; bf16_t* rowp = X + (size_t)(row0 + ai * HALF + m * 16) * ldc + col0 + bj * HALF;
                    const float rs = sr.y, nc = -sr.x * sr.y; const f32x4 y0 = (acc[ai][bj][m][0] * rs + nc) * g0 + b0, y1 = (acc[ai][bj][m][1] * rs + nc) * g1 + b1;
                    u32x4 w; w.x = cvt_pk_bf16(y0[0], y0[1]); w.y = cvt_pk_bf16(y0[2], y0[3]); w.z = cvt_pk_bf16(y1[0], y1[1]); w.w = cvt_pk_bf16(y1[2], y1[3]);
                    *(u32x4*)rowp = w; } }
    }
};
__device__ __forceinline__ float clamp448(float v) { return __builtin_fminf(__builtin_fmaxf(v, -448.f), 448.f); }
__device__ __forceinline__ unsigned pk_fp8x4(float a, float b, float c, float d) {
    int v = __builtin_amdgcn_cvt_pk_fp8_f32(clamp448(a), clamp448(b), 0, false); v = __builtin_amdgcn_cvt_pk_fp8_f32(clamp448(c), clamp448(d), v, true); return (unsigned)v; }
struct EpiSwiGLU8 {
    static constexpr bool PERM = true;
    unsigned char* O; int ldc; float iscale, hscale;
    __device__ __forceinline__ void operator()(const f32x4 (&acc)[2][2][4][2], const Unit& u, int wr, int wc, int fr, int fq) const {
        const int row0 = u.pm * BM + wr * 64 + fr, col0 = u.pn * HALF + wc * 32 + 8 * fq;
        const float ke = -1.4426950408889634f * iscale, ikh = 1.0f / (iscale * iscale * hscale);
        const f32x2 ke2 = (f32x2){ke, ke}, ikh2 = (f32x2){ikh, ikh};
#pragma unroll
        for (int ai = 0; ai < 2; ++ai)
#pragma unroll
            for (int m = 0; m < 4; ++m) { unsigned char* rowp = O + (size_t)(row0 + ai * HALF + m * 16) * ldc + col0; f32x2 hv[4];
#pragma unroll
                for (int n = 0; n < 2; ++n)
#pragma unroll
                    for (int jj = 0; jj < 2; ++jj) { const f32x4 g4 = acc[ai][0][m][n], u4 = acc[ai][1][m][n];
                        const f32x2 g = jj ? (f32x2){g4[2], g4[3]} : (f32x2){g4[0], g4[1]}, up = jj ? (f32x2){u4[2], u4[3]} : (f32x2){u4[0], u4[1]};
                        const f32x2 t = g * ke2; f32x2 e; e[0] = __builtin_amdgcn_exp2f(t[0]); e[1] = __builtin_amdgcn_exp2f(t[1]);
                        const f32x2 d = e * ikh2 + ikh2; f32x2 r; r[0] = __builtin_amdgcn_rcpf(d[0]); r[1] = __builtin_amdgcn_rcpf(d[1]);
                        hv[n * 2 + jj] = (g * up) * r; }
                u32x2 w; { int v0 = __builtin_amdgcn_cvt_pk_fp8_f32(hv[0][0], hv[0][1], 0, false); v0 = __builtin_amdgcn_cvt_pk_fp8_f32(hv[1][0], hv[1][1], v0, true);
                           int v1 = __builtin_amdgcn_cvt_pk_fp8_f32(hv[2][0], hv[2][1], 0, false); v1 = __builtin_amdgcn_cvt_pk_fp8_f32(hv[3][0], hv[3][1], v1, true); w.x = (unsigned)v0; w.y = (unsigned)v1; }
                *(u32x2*)rowp = w; }
    }
};

__device__ __forceinline__ void glds16s(const void* sbase, unsigned voff, unsigned lds_dst) { unsigned keep;
    asm volatile("s_mov_b32 %0, m0\n\ts_mov_b32 m0, %3\n\ts_nop 0\n\tglobal_load_lds_dwordx4 %1, %2\n\ts_mov_b32 m0, %0" : "=&s"(keep) : "v"(voff), "s"(sbase), "s"(lds_dst) : "memory"); }
template <class Epi, class Sched, bool FP8 = false>
__device__ __forceinline__ void gemm_phase(PG8_LAS unsigned char* lds, const Gemm g, const Sched& S, const Epi& E) {
    constexpr bool GATHER = Sched::GATHER; constexpr bool ASM_DMA = FP8 || PG8_ASM_DMA_ALL;
    int tid = threadIdx.x; asm volatile("" : "+v"(tid));
    const int wid = __builtin_amdgcn_readfirstlane(tid >> 6), lane = tid & 63, wr = wid >> 2, wc = wid & 3, fr = lane & 15, fq = lane >> 4;
    const int K = FP8 ? g.K / 2 : g.K, nt = K / BK;
    unsigned voffA[2], voffB[2]; int RA[2];
#pragma unroll
    for (int i = 0; i < 2; ++i) { int R, C; stage_rc(tid * 16 + i * 8192, R, C); const int Rb = Epi::PERM ? ((R & ~31) + perm32(R & 31)) : R;
        RA[i] = R; voffA[i] = GATHER ? (unsigned)C * 2u : (unsigned)(R * K + C) * 2u; voffB[i] = (unsigned)(Rb * K + C) * 2u; }
    const unsigned K2 = (unsigned)K * 2u;
    const size_t kstep = (size_t)(BK * 2);
    const size_t hstep = (size_t)HALF * K * 2;
    const size_t tstep = 2 * hstep;
    const unsigned ldsw = (unsigned)wid * 1024u; const unsigned ldsb = (unsigned)(uintptr_t)lds;
    const int aoff = lds_byte(wr * 64 + fr, fq * 8), boff = lds_byte(wc * 32 + fr, fq * 8);
#define PG8_SA(b, h) (((b) * 2 + (h)) * HTB)
#define PG8_SB(b, h) ((4 + (b) * 2 + (h)) * HTB)
#define PG8_STAGE(bufoff, gbase, voff) do { _Pragma("unroll") for (int _i = 0; _i < 2; ++_i) { \
        if (ASM_DMA) glds16s((const char*)(gbase), (voff)[_i], (unsigned)__builtin_amdgcn_readfirstlane((int)(ldsb + (unsigned)(bufoff) + ldsw + _i * 8192u))); \
        else __builtin_amdgcn_global_load_lds((const unsigned*)((const char*)(gbase) + (size_t)(voff)[_i]), (PG8_LAS unsigned*)(lds + (bufoff) + ldsw + _i * 8192), 16, 0, 0); } } while (0)
#define PG8_STAGE_A(bufoff, ub, kb, h, go) do { if (GATHER) PG8_STAGE(bufoff, (ub) + (kb), (go)[h]); else PG8_STAGE(bufoff, (ub) + (kb) + (size_t)(h) * hstep, voffA); } while (0)
#define PG8_LD8(p_) __builtin_shufflevector(*(const PG8_LAS v4i_t*)(p_), *(const PG8_LAS v4i_t*)((p_) + 1024), 0, 1, 2, 3, 4, 5, 6, 7)
#define PG8_LDA(dst, b, h) do { _Pragma("unroll") for (int m = 0; m < 4; ++m) { if (FP8) dst##8[m] = PG8_LD8(lds + PG8_SA(b, h) + aoff + m * 2048); else { _Pragma("unroll") for (int k = 0; k < 2; ++k) dst[m][k] = *(const PG8_LAS bf16x8*)(lds + PG8_SA(b, h) + aoff + m * 2048 + k * 1024); } } } while (0)
#define PG8_LDB(dst, b, h) do { _Pragma("unroll") for (int n = 0; n < 2; ++n) { if (FP8) dst##8[n] = PG8_LD8(lds + PG8_SB(b, h) + boff + n * 2048); else { _Pragma("unroll") for (int k = 0; k < 2; ++k) dst[n][k] = *(const PG8_LAS bf16x8*)(lds + PG8_SB(b, h) + boff + n * 2048 + k * 1024); } } } while (0)
#define PG8_MMA_REAL(ai, bj, At, Bt) do { __builtin_amdgcn_s_setprio(1); _Pragma("unroll") for (int m = 0; m < 4; ++m) _Pragma("unroll") for (int n = 0; n < 2; ++n) { \
        if (FP8) asm("v_mfma_scale_f32_16x16x128_f8f6f4 %0, %1, %2, %0, %3, %3 op_sel_hi:[0,0,0]" : "+v"(acc[ai][bj][m][n]) : "v"(Bt##8[n]), "v"(At##8[m]), "v"(sc1));   \
        else { _Pragma("unroll") for (int k = 0; k < 2; ++k) acc[ai][bj][m][n] = __builtin_amdgcn_mfma_f32_16x16x32_bf16(Bt[n][k], At[m][k], acc[ai][bj][m][n], 0, 0, 0); } } \
        __builtin_amdgcn_s_setprio(0); } while (0)
#define PG8_MMA(ai, bj, At, Bt) PG8_MMA_REAL(ai, bj, At, Bt)
#define PG8_WAIT_V(n) asm volatile("s_waitcnt vmcnt(" #n ")" ::: "memory")
#define PG8_WAIT_L(n) asm volatile("s_waitcnt lgkmcnt(" #n ")" ::: "memory")
#define PG8_BAR __builtin_amdgcn_s_barrier()
#define PG8_SCHED __builtin_amdgcn_sched_barrier(0)
#define PG8_OFFS(dst, ui_, u_) do { _Pragma("unroll") for (int _h = 0; _h < 2; ++_h) _Pragma("unroll") for (int _i = 0; _i < 2; ++_i) dst[_h][_i] = GATHER ? S.a_row(ui_, u_, _h * HALF + RA[_i]) * K2 + voffA[_i] : 0u; } while (0)
    Unit cur, nxt; int ui = 0;
    if (!S.next(0, cur)) return;
    f32x4 acc[2][2][4][2];
#pragma unroll
    for (int a = 0; a < 2; ++a)
#pragma unroll
        for (int b = 0; b < 2; ++b)
#pragma unroll
            for (int m = 0; m < 4; ++m)
#pragma unroll
                for (int n = 0; n < 2; ++n) acc[a][b][m][n] = (f32x4){0.f, 0.f, 0.f, 0.f};
    bf16x8 At[4][2], B0[2][2], B1[2][2];
    v8i_t At8[4], B08[2], B18[2];
    const int sc1 = 0x7f7f7f7f;
    unsigned offA[2][2];
    PG8_OFFS(offA, 0, cur);
    const char* cA = (const char*)g.A + (GATHER ? (size_t)0 : (size_t)cur.pm * tstep);
    const char* cB = (const char*)g.Bt + (size_t)cur.pb * tstep;
    PG8_STAGE(PG8_SB(0, 0), cB, voffB); PG8_STAGE(PG8_SB(0, 1), cB + hstep, voffB); PG8_STAGE_A(PG8_SA(0, 0), cA, 0, 0, offA); PG8_STAGE_A(PG8_SA(0, 1), cA, 0, 1, offA);
    if (wr == 1) PG8_BAR;
    PG8_WAIT_V(2); PG8_BAR;
    PG8_STAGE(PG8_SB(1, 0), cB + kstep, voffB); PG8_STAGE_A(PG8_SA(1, 0), cA, kstep, 0, offA); PG8_STAGE(PG8_SB(1, 1), cB + hstep + kstep, voffB);
    PG8_WAIT_V(6); PG8_BAR;
    for (;;) {
        const bool has_next = S.next(ui + 1, nxt);
        const char* nA = (has_next && !GATHER) ? (const char*)g.A + (size_t)nxt.pm * tstep : cA; const char* nB = has_next ? (const char*)g.Bt + (size_t)nxt.pb * tstep : cB;
        for (int t = 0; t < nt; t += 2) {
            const bool last = (t == nt - 2);
            const size_t k1 = (size_t)(t + 1) * kstep;
            const char* a2 = last ? nA : cA; const size_t k2 = last ? (size_t)0 : (size_t)(t + 2) * kstep; const char* b2 = last ? nB : cB + (size_t)(t + 2) * kstep;
            const size_t k3 = k2 + kstep; const char* b3 = b2 + kstep;
            unsigned o2[2][2];
#pragma unroll
            for (int h = 0; h < 2; ++h)
#pragma unroll
                for (int i = 0; i < 2; ++i) o2[h][i] = offA[h][i];
            if (GATHER && last && has_next) { PG8_OFFS(o2, ui + 1, nxt); }
            PG8_LDB(B0, 0, 0); PG8_LDB(B1, 0, 1); PG8_SCHED; PG8_LDA(At, 0, 0); PG8_STAGE_A(PG8_SA(1, 1), cA, k1, 1, offA);
            PG8_WAIT_V(8); PG8_WAIT_L(0); PG8_BAR; PG8_MMA(0, 0, At, B0); PG8_MMA(0, 1, At, B1); PG8_BAR; PG8_SCHED;
            PG8_LDA(At, 0, 1); PG8_STAGE(PG8_SB(0, 0), b2, voffB); PG8_STAGE(PG8_SB(0, 1), b2 + hstep, voffB); PG8_STAGE_A(PG8_SA(0, 0), a2, k2, 0, o2);
            PG8_WAIT_V(8); PG8_WAIT_L(0); PG8_BAR; PG8_MMA(1, 0, At, B0); PG8_MMA(1, 1, At, B1); PG8_BAR; PG8_SCHED;
            PG8_LDB(B0, 1, 0); PG8_LDB(B1, 1, 1); PG8_SCHED; PG8_LDA(At, 1, 0); PG8_STAGE_A(PG8_SA(0, 1), a2, k2, 1, o2);
            PG8_WAIT_V(8); PG8_WAIT_L(0); PG8_BAR; PG8_MMA(0, 0, At, B0); PG8_MMA(0, 1, At, B1); PG8_BAR; PG8_SCHED;
            PG8_LDA(At, 1, 1); PG8_STAGE(PG8_SB(1, 0), b3, voffB); PG8_STAGE(PG8_SB(1, 1), b3 + hstep, voffB); PG8_STAGE_A(PG8_SA(1, 0), a2, k3, 0, o2);
            PG8_WAIT_V(8); PG8_WAIT_L(0); PG8_BAR; PG8_MMA(1, 0, At, B0); PG8_MMA(1, 1, At, B1); PG8_BAR; PG8_SCHED;
            if (GATHER && last) {
#pragma unroll
                for (int h = 0; h < 2; ++h)
#pragma unroll
                    for (int i = 0; i < 2; ++i) offA[h][i] = o2[h][i]; }
        }
        if (FP8) asm volatile("s_nop 15\n\ts_nop 15" ::: "memory");
        if (wr == 0) PG8_BAR;
        E(acc, cur, wr, wc, fr, fq);
        if (!has_next) break;
#pragma unroll
        for (int a = 0; a < 2; ++a)
#pragma unroll
            for (int b = 0; b < 2; ++b)
#pragma unroll
                for (int m = 0; m < 4; ++m)
#pragma unroll
                    for (int n = 0; n < 2; ++n) acc[a][b][m][n] = (f32x4){0.f, 0.f, 0.f, 0.f};
        cur = nxt; cA = nA; cB = nB; ++ui;
        if (wr == 1) PG8_BAR;
    }
    PG8_WAIT_V(0);
    PG8_BAR;
#undef PG8_SA
#undef PG8_SB
#undef PG8_STAGE
#undef PG8_STAGE_A
#undef PG8_LDA
#undef PG8_LDB
#undef PG8_MMA
#undef PG8_MMA_REAL
#undef PG8_LD8
#undef PG8_WAIT_V
#undef PG8_WAIT_L
#undef PG8_BAR
#undef PG8_SCHED
#undef PG8_OFFS
}
}
namespace attn_body {
using bf16=__hip_bfloat16;
using bf16x8=__attribute__((ext_vector_type(8)))short;
using s16x4=__attribute__((ext_vector_type(4)))short;
using f32x16=__attribute__((ext_vector_type(16)))float;
using f32x4=__attribute__((ext_vector_type(4)))float;
using u32x4=__attribute__((ext_vector_type(4)))unsigned;
using u32x2=__attribute__((ext_vector_type(2)))unsigned;
using v4i=__attribute__((ext_vector_type(4)))int;
using v8i=__attribute__((ext_vector_type(8)))int;
constexpr int BATCH=8,NHEAD=4,SEQ=8192,D=64;
constexpr int ZP=1280;
constexpr int YP=1024;
constexpr int QCOL=768,KCOL=1024,VCOL=1280,OCOL=512;
constexpr int NW=8,QBLK=32,QB=QBLK*NW,KVBLK=64,NQB=SEQ/QB;
__device__ __forceinline__ int crow(int r,int hi){return (r&3)+8*(r>>2)+4*hi;}
#define SBAR() __builtin_amdgcn_sched_barrier(0)
__device__ __forceinline__ void cmask(f32x16&p0,f32x16&p1,int jb,int qrel,int hi){
  const float NEG=-INFINITY; int qd=qrel-64*jb-4*hi; asm volatile("":"+v"(qd));
  #pragma unroll
  for(int r=0;r<16;++r){const int kc=(r&3)+8*(r>>2); if(kc>qd)p0[r]=NEG; if(kc+32>qd)p1[r]=NEG;}
}
constexpr int NSLOT=3, SLOTB=8192;
constexpr int LDS_K=0, LDS_V=NSLOT*SLOTB, LDS_WS=2*NSLOT*SLOTB, LDS_OST=LDS_WS+NW*64*4, LDS_ONES=LDS_OST+NW*8192, LDS_BYTES=LDS_ONES+64;
constexpr float C2=8.0f*0.17677669529663687f*1.4426950408889634f;
constexpr float PSH=4.0f;
constexpr float K0=8.0f*(PSH+7.0f)+0.5f;
__device__ __forceinline__ void glds16(const void*sbase,unsigned voff,unsigned lds_dst){unsigned keep;
  asm volatile("s_mov_b32 %0, m0\n\ts_mov_b32 m0, %3\n\ts_nop 0\n\tglobal_load_lds_dwordx4 %1, %2\n\ts_mov_b32 m0, %0":"=&s"(keep):"v"(voff),"s"(sbase),"s"(lds_dst):"memory");}
__device__ __forceinline__ float max3f(float a,float b,float c){float r;asm("v_max3_f32 %0, %1, %2, %3":"=v"(r):"v"(a),"v"(b),"v"(c));return r;}
__device__ __forceinline__ float max2f(float a,float b){float r;asm("v_max_f32_e32 %0, %1, %2":"=v"(r):"v"(a),"v"(b));return r;}
__device__ __forceinline__ float fadd_s(float a,float b){float r;asm("v_add_f32_e32 %0, %1, %2":"=v"(r):"v"(a),"v"(b));return r;}
__device__ __forceinline__ float fsub_s(float a,float b){float r;asm("v_sub_f32_e32 %0, %1, %2":"=v"(r):"v"(a),"v"(b));return r;}
typedef float f32x2_t __attribute__((ext_vector_type(2))); typedef __bf16 bf16x2_t __attribute__((ext_vector_type(2)));
__device__ __forceinline__ unsigned cvtpk_s(float lo,float hi){f32x2_t v={lo,hi};bf16x2_t b=__builtin_convertvector(v,bf16x2_t);return __builtin_bit_cast(unsigned,b);}
#define WAIT_BAR(N) asm volatile("s_waitcnt vmcnt(" #N ") lgkmcnt(0)\n\ts_barrier":::"memory")
#define WAIT_BAR_KV(NK,NV) do{ if(isK){WAIT_BAR(NK);} else {WAIT_BAR(NV);} }while(0)
typedef __attribute__((address_space(3))) const char* lds_cptr;
typedef short v4i16_t __attribute__((ext_vector_type(4)));
__device__ __forceinline__ void kload2(bf16x8*kf,lds_cptr kp,int ka,int kb,int j){ const int o=j?kb:ka; kf[2*j]=*(const __attribute__((address_space(3))) bf16x8*)(kp+o); kf[2*j+1]=*(const __attribute__((address_space(3))) bf16x8*)(kp+o+2048); }
__device__ __forceinline__ float rowmax(const f32x16&p0,const f32x16&p1){
  float a=max3f(p0[0],p0[1],p1[0]),b=max3f(p0[2],p0[3],p1[1]);a=max3f(a,p1[2],p1[3]);
  #pragma unroll
  for(int r=4;r<16;r+=4){a=max3f(a,p0[r],p0[r+1]);b=max3f(b,p0[r+2],p0[r+3]);a=max3f(a,p1[r],p1[r+1]);b=max3f(b,p1[r+2],p1[r+3]);}
  const float m=max2f(a,b);
  auto rr=__builtin_amdgcn_permlane32_swap(__float_as_uint(m),__float_as_uint(m),false,false);
  return max2f(__uint_as_float(rr[0]),__uint_as_float(rr[1]));
}

struct AttnParams { const bf16* Z; bf16* Y; float lam; float osc; const float* subg; const unsigned char* V8; const unsigned char* KT; };
template<int THRL> __device__ __forceinline__ void attn_unit(int b,int h,int qb,const AttnParams&P,char*shm){
  int tid=threadIdx.x; asm volatile("":"+v"(tid));
  const int lane=tid&63,r32=lane&31,hi=lane>>5; const int wid=__builtin_amdgcn_readfirstlane(tid>>6);
  const long rowbase=(long)b*SEQ; const int q0=qb*QB;
  const bf16*Z=P.Z;
  const unsigned lds0=(unsigned)(uintptr_t)shm;
  float*wsf=(float*)(shm+LDS_WS)+wid*64;
  if(tid<8)((unsigned*)(shm+LDS_ONES))[tid]=0x38383838u;
  const unsigned char*KTh=P.KT+(size_t)((b*NHEAD+h)*2)*(128*4096);
  const bool isK=wid<4;
  const unsigned doff=(unsigned)((wid&3)*1024+lane*16);
  const unsigned char*V8h=P.V8+(size_t)(b*NHEAD+h)*(128*4096);
  const unsigned ddst=lds0+(isK?LDS_K:LDS_V)+(wid&3)*1024;
  const long dstep=4096L;
  #define DMA_K(t,slot) do{ if(isK){ glds16(pn,doff,(unsigned)__builtin_amdgcn_readfirstlane(ddst+(slot))); pn+=dstep; } }while(0)
  #define DMA_V(t,slot) do{ if(!isK){ glds16(pn,doff,(unsigned)__builtin_amdgcn_readfirstlane(ddst+(slot))); pn+=dstep; } }while(0)
  const lds_cptr shm3=(lds_cptr)shm; const lds_cptr vp0=shm3+LDS_V+hi*2048+r32*16;
  const int NT=(q0+QB)/KVBLK;
  const int qrel=wid*QBLK+r32;
  for(int mp=0;mp<2;++mp){
  const bf16*Qw=Z+(rowbase+q0+wid*QBLK)*ZP+QCOL+h*D+mp*32;
  const lds_cptr kp0=shm3+LDS_K; const int ka=r32*64+((hi^((r32>>2)&3))*16), kb=ka^32;
  bf16x8 kf[4];
  const char*pn=isK?(const char*)(KTh+(size_t)mp*(128*4096)):(const char*)V8h;
  DMA_K(0,0);DMA_V(0,0);DMA_K(1,SLOTB);
  bf16x8 qr[2];
  #pragma unroll
  for(int d0=0;d0<2;++d0)qr[d0]=*reinterpret_cast<const bf16x8*>(&Qw[(long)r32*ZP+d0*16+hi*8]);
  float mhat=0.f;f32x16 o[2];o[0]=f32x16{};o[1]=f32x16{};f32x4 osum=f32x4{};f32x16 negm; { float z0_; asm volatile("v_mov_b32 %0, %1":"=v"(z0_):"s"(K0)); _Pragma("unroll") for(int r=0;r<16;++r)negm[r]=z0_; } asm volatile("":"+v"(negm));
  int sc1=0x7f7f7f7f;asm volatile("":"+v"(sc1));
  v8i onesB; { int ob_=(((lane>>4)&1)==((lane>>3)&1))?0x38383838:0; asm volatile("":"+v"(ob_)); _Pragma("unroll") for(int r=0;r<8;++r)onesB[r]=ob_; } asm volatile("":"+v"(onesB));
  #define CMASK(P0,P1,t) do{int jb_=(t)-(NT-4); if(jb_>=0)cmask(P0,P1,jb_,qrel,hi);}while(0)
  bool resc=false;
  #define START(P0,P1) do{ const float rm=rowmax(P0,P1); resc=false; \
    { const float dl=rm-K0; mhat=fadd_s(mhat,dl); \
      _Pragma("unroll") for(int r=0;r<16;++r){P0[r]=fsub_s(P0[r],dl);P1[r]=fsub_s(P1[r],dl);} \
      _Pragma("unroll") for(int r=0;r<16;++r)negm[r]=K0-mhat; asm volatile("":"+v"(negm)); } }while(0)
  #define RESC() do{ if(resc){ asm volatile("s_waitcnt lgkmcnt(0)\n\ts_nop 15\n\ts_nop 15\n\ts_nop 15\n\ts_nop 15\n\ts_nop 15":"+v"(o[0]),"+v"(o[1]),"+v"(osum)::"memory");   \
      _Pragma("unroll") for(int r=0;r<16;++r){const float f_=wsf[crow(r,hi)];o[0][r]*=f_;o[1][r]*=f_;} \
      _Pragma("unroll") for(int i=0;i<4;++i)osum[i]*=wsf[4*(lane>>4)+16*((lane>>3)&1)+i]; } }while(0)
  f32x16 pA0,pA1; v8i pwA,pwB;
  int sl_prev=0,sl_cur=0,sl_next=SLOTB;
  #define ROT() do{sl_prev=sl_cur;sl_cur=sl_next;sl_next=(sl_next==(NSLOT-1)*SLOTB)?0:sl_next+SLOTB;}while(0)
  DMA_K(2,2*SLOTB);
  WAIT_BAR(2);
  { kload2(kf,kp0,ka,kb,0); kload2(kf,kp0,ka,kb,1);
    pA0=__builtin_amdgcn_mfma_f32_32x32x16_bf16(kf[0],qr[0],negm,0,0,0); pA1=__builtin_amdgcn_mfma_f32_32x32x16_bf16(kf[1],qr[0],negm,0,0,0);
    pA0=__builtin_amdgcn_mfma_f32_32x32x16_bf16(kf[2],qr[1],pA0,0,0,0);  pA1=__builtin_amdgcn_mfma_f32_32x32x16_bf16(kf[3],qr[1],pA1,0,0,0); }
  asm volatile("s_nop 15\n\ts_nop 7":"+v"(pA0),"+v"(pA1));CMASK(pA0,pA1,0);
  START(pA0,pA1);
  #define CV4(P,B) __builtin_amdgcn_cvt_pk_u8_f32(P[(B)+3],3,__builtin_amdgcn_cvt_pk_u8_f32(P[(B)+2],2,__builtin_amdgcn_cvt_pk_u8_f32(P[(B)+1],1,__builtin_amdgcn_cvt_pk_u8_f32(P[B],0,0u))))
  #define PACK(PW,P0,P1) do{ PW[0]=(int)CV4(P0,0);PW[1]=(int)CV4(P0,4);PW[2]=(int)CV4(P0,8);PW[3]=(int)CV4(P0,12);PW[4]=(int)CV4(P1,0);PW[5]=(int)CV4(P1,4);PW[6]=(int)CV4(P1,8);PW[7]=(int)CV4(P1,12); }while(0)
  PACK(pwA,pA0,pA1);
  WAIT_BAR(0);
  DMA_K(3,0);DMA_V(1,SLOTB);
  ROT();
  kload2(kf,kp0+sl_cur,ka,kb,0); kload2(kf,kp0+sl_cur,ka,kb,1);
  WAIT_BAR(1);
  v8i vf8[2];
  #define PIN(x) asm volatile("":"+v"(x))
  #define MX3(a,b,c) __builtin_fmaxf(__builtin_fmaxf((a),(b)),(c))
  #define MF8(ACC,B8,PW) asm volatile("v_mfma_scale_f32_32x32x64_f8f6f4 %0, %1, %2, %0, %3, %3 op_sel_hi:[0,0,0]":"+v"(ACC):"v"(PW),"v"(B8),"v"(sc1))
  #define MFS(ACC,PW) asm volatile("v_mfma_scale_f32_16x16x128_f8f6f4 %0, %1, %2, %0, %3, %3 op_sel_hi:[0,0,0]":"+v"(ACC):"v"(PW),"v"(onesB),"v"(sc1))
  #define ONES8() do{ const v4i a_=*(const __attribute__((address_space(3))) v4i*)(shm3+LDS_ONES), b_=*(const __attribute__((address_space(3))) v4i*)(shm3+LDS_ONES+16); vf8[0]=__builtin_shufflevector(a_,b_,0,1,2,3,4,5,6,7); }while(0)
  #define VRD8(d0) do{ const v4i a_=*(const __attribute__((address_space(3))) v4i*)(vp_+(d0)*512), b_=*(const __attribute__((address_space(3))) v4i*)(vp_+(d0)*512+1024); vf8[d0]=__builtin_shufflevector(a_,b_,0,1,2,3,4,5,6,7); }while(0)
  #define KRD(G,j) do{ if(G){ kload2(kf,kp0+sl_next,ka,kb,j); SBAR(); } }while(0)
  #define STEP(C0,C1,PWP,PWN,t,GK,GV,GL) do{ SBAR(); \
    const lds_cptr vp_=vp0+sl_prev; \
    VRD8(0); SBAR(); \
    C0=__builtin_amdgcn_mfma_f32_32x32x16_bf16(kf[0],qr[0],negm,0,0,0); \
    C1=__builtin_amdgcn_mfma_f32_32x32x16_bf16(kf[1],qr[0],negm,0,0,0); \
    VRD8(1); SBAR(); \
    C0=__builtin_amdgcn_mfma_f32_32x32x16_bf16(kf[2],qr[1],C0,0,0,0); \
    C1=__builtin_amdgcn_mfma_f32_32x32x16_bf16(kf[3],qr[1],C1,0,0,0); \
    if(GK){DMA_K((t)+3,sl_cur);} if(GV){DMA_V((t)+1,sl_next);} \
    CMASK(C0,C1,t); \
    { float a=MX3(C0[0],C0[1],C1[0]),b=MX3(C0[2],C0[3],C1[1]); a=MX3(a,C1[2],C1[3]); \
      _Pragma("unroll") for(int r=4;r<16;r+=4){a=MX3(a,C0[r],C0[r+1]);b=MX3(b,C0[r+2],C0[r+3]);a=MX3(a,C1[r],C1[r+1]);b=MX3(b,C1[r+2],C1[r+3]);} \
      float rm=__builtin_fmaxf(a,b); { auto rr=__builtin_amdgcn_permlane32_swap(__float_as_uint(rm),__float_as_uint(rm),false,false); rm=__builtin_fmaxf(__uint_as_float(rr[0]),__uint_as_float(rr[1])); } \
      resc=false; \
      if(__builtin_expect(__any(rm>8.0f*(float)THRL+K0),0)){ const float dl=__builtin_fmaxf(rm-K0,0.f); mhat+=dl; \
        _Pragma("unroll") for(int r=0;r<16;++r){C0[r]-=dl;C1[r]-=dl;} \
        _Pragma("unroll") for(int r=0;r<16;++r)negm[r]=K0-mhat; asm volatile("":"+v"(negm)); \
        const float f=__builtin_amdgcn_exp2f(-0.125f*dl); if(hi==0)wsf[r32]=f; resc=true; } } \
    SBAR(); \
    MF8(o[0],vf8[0],PWP); PWN[0]=(int)CV4(C0,0);PWN[1]=(int)CV4(C0,4);PWN[2]=(int)CV4(C0,8);PWN[3]=(int)CV4(C0,12); PIN(PWN); SBAR(); \
    KRD(GL,0); \
    MF8(o[1],vf8[1],PWP); PWN[4]=(int)CV4(C1,0);PWN[5]=(int)CV4(C1,4);PWN[6]=(int)CV4(C1,8);PWN[7]=(int)CV4(C1,12); PIN(PWN); SBAR(); \
    KRD(GL,1); \
    MFS(osum,PWP); SBAR(); \
    }while(0)
  int t=1;
  #undef CMASK
  #define CMASK(P0,P1,t) do{}while(0)
  for(;t+5<NT;t+=2){
    STEP(pA0,pA1,pwA,pwB,t,true,true,true);     WAIT_BAR(1); RESC(); ROT();
    STEP(pA0,pA1,pwB,pwA,t+1,true,true,true);   WAIT_BAR(1); RESC(); ROT();
  }
  #undef CMASK
  #define CMASK(P0,P1,t) do{int jb_=(t)-(NT-4); if(jb_>=0)cmask(P0,P1,jb_,qrel,hi);}while(0)
  #define ENDW(tt) do{ if((tt)+3<NT){WAIT_BAR(1);} else if((tt)+2<NT){WAIT_BAR_KV(0,1);} else {WAIT_BAR(0);} }while(0)
  for(;t+1<NT;t+=2){
    STEP(pA0,pA1,pwA,pwB,t,(t+3<NT),(t+1<NT),(t+1<NT));       ENDW(t);   RESC(); ROT();
    STEP(pA0,pA1,pwB,pwA,t+1,(t+4<NT),(t+2<NT),(t+2<NT));     ENDW(t+1); RESC(); ROT();
  }
  STEP(pA0,pA1,pwA,pwB,NT-1,false,false,false); RESC();
  { const lds_cptr vp_=vp0+sl_cur; VRD8(0); VRD8(1); SBAR();
    asm volatile("s_nop 7":::"memory");
    MF8(o[0],vf8[0],pwB); MF8(o[1],vf8[1],pwB); asm volatile("s_nop 15":::"memory"); MFS(osum,pwB);
    asm volatile("s_nop 15\n\ts_nop 15\n\ts_nop 15\n\ts_nop 15\n\ts_nop 15":"+v"(o[0]),"+v"(o[1]),"+v"(osum)); }
  #undef CV4
  #undef PACK
  #undef PIN
  #undef MX3
  #undef MF8
  #undef VRD8
  #undef ONES8
  #undef MFS
  #undef KRD
  #undef STEP
  #undef ENDW
  #undef CMASK
  #undef START
  #undef RESC
  #undef ROT
  { int le=lane; asm volatile("":"+v"(le)); const int r32e=le&31,hie=le>>5;
    float*oste=(float*)(shm+LDS_OST)+wid*2048;
    float rli[16];
    #pragma unroll
    for(int r=0;r<16;++r)rli[r]=0.f;
    { float*wse=(float*)(shm+LDS_WS)+wid*64;
      if((le&7)==0){ const int q_=4*(le>>4)+16*((le>>3)&1); _Pragma("unroll") for(int i=0;i<4;++i)wse[q_+i]=osum[i]; }
      asm volatile("s_waitcnt lgkmcnt(0)":::"memory");
      _Pragma("unroll") for(int r=0;r<16;++r)rli[r]=__builtin_amdgcn_rcpf(wse[(r&3)+8*(r>>2)+4*hie]);
      asm volatile("s_waitcnt lgkmcnt(0)":::"memory"); }
    if(mp==0){
      float*pk=oste+le;
      #pragma unroll
      for(int d0=0;d0<2;++d0)
        #pragma unroll
        for(int r=0;r<16;++r)pk[(d0*16+r)*64]=o[d0][r]*rli[r];
    } else {
      const float lam=P.lam; const float*pk=oste+le;
      #pragma unroll
      for(int d0=0;d0<2;++d0)
        #pragma unroll
        for(int r=0;r<16;++r)o[d0][r]=pk[(d0*16+r)*64]-lam*(o[d0][r]*rli[r]);
      asm volatile("s_waitcnt lgkmcnt(0)":::"memory");
      { float*st=oste+(4*hie)*64+r32e;
        #pragma unroll
        for(int r=0;r<16;++r){
          #pragma unroll
          for(int d0=0;d0<2;++d0)st[((r&3)+8*(r>>2))*64+d0*32]=o[d0][r];} }
      asm volatile("s_waitcnt lgkmcnt(0)":::"memory");
      const int ch=le&15, rw=le>>4;
      bf16*Ow=P.Y+(rowbase+q0+wid*QBLK+rw)*YP+OCOL+h*D+ch*4;
      const float*rd=oste+rw*64+ch*4;
      const f32x4 gv=*(const f32x4*)(P.subg+ch*4); const float osc=P.osc;
      #pragma unroll
      for(int i=0;i<8;++i){ const f32x4 v=*(const f32x4*)(rd+i*256);
        float ss=(v[0]*v[0]+v[1]*v[1])+(v[2]*v[2]+v[3]*v[3]);
        ss+=__shfl_xor(ss,1); ss+=__shfl_xor(ss,2); ss+=__shfl_xor(ss,4); ss+=__shfl_xor(ss,8);
        const float rs=(1.0f/sqrtf(ss*(1.0f/64.0f)+1e-5f))*osc;
        u32x2 w; w.x=cvtpk_s(v[0]*rs*gv[0],v[1]*rs*gv[1]); w.y=cvtpk_s(v[2]*rs*gv[2],v[3]*rs*gv[3]);
        *(u32x2*)(Ow+(long)i*4*YP)=w; }
    }
  }
  asm volatile("s_waitcnt lgkmcnt(0)\n\ts_barrier":::"memory");
  }
  #undef DMA_K
  #undef DMA_V
}
constexpr int ATTN_LDS_BYTES=LDS_BYTES;
template<int THRL=8> __device__ __forceinline__ void attn_phase(char*lds,const AttnParams&P,int vcu,int G){
  for(int w=vcu;w<256;w+=G){
    const int s=w&7,bh=w>>3;
    for(int i=0;i<4;++i){ const int qb=(i==0)?s:(i==1)?15-s:(i==2)?16+s:31-s; attn_unit<THRL>(bh/NHEAD,bh%NHEAD,qb,P,lds); }
  }
}
#undef SBAR
#undef WAIT_BAR
}
constexpr int NWAVES = 8;
constexpr int BATCH = 8, SEQ = 8192, D = 1024, M = BATCH * SEQ, DEPTH = 4;
constexpr int NZ = 2304, FF = 2816, FE = 3584, NE = 8;
constexpr int ZW = 1280;
constexpr int NGU = 2 * FF, NGUE = 2 * FE;
constexpr float LN_EPS = 1e-5f;
constexpr float DN_ALPHA = 1.6817928305074292f;
constexpr int MOE_CH = 256;
constexpr int MOE_NCH = 2;
constexpr int MOE_SEAMS = 4;
constexpr int MOE_MAXU = 520;
constexpr size_t MiB = 1u << 20;
constexpr size_t WS_CTL = 0, CTL_ZERO_BYTES = 128 * 1024;
constexpr size_t WS_WIN = 1 * MiB;
constexpr size_t WS_WO = 19 * MiB;
constexpr size_t WS_WGU = 27 * MiB;
constexpr size_t WS_WD = 49 * MiB;
constexpr size_t WS_MGU = 60 * MiB;
constexpr size_t WS_MD = 172 * MiB;
constexpr size_t WS_V8T = 292 * MiB;
constexpr size_t WS_XLN = 310 * MiB;
constexpr size_t WS_WGU8 = 314 * MiB;
constexpr size_t WS_KT = 348 * MiB;
constexpr size_t WS_V8R = 330 * MiB;
constexpr size_t WS_XB8 = 228 * MiB;
constexpr float W1_SCALE = 32.f, WD_SCALE = 128.f, H_SCALE = 4.f;
constexpr size_t WS_ROPE = 396 * MiB;
constexpr size_t WS_LIST = 398 * MiB;
constexpr size_t WS_TOK = 400 * MiB;
constexpr size_t WS_XB = 401 * MiB;
constexpr size_t WS_R = 529 * MiB;
constexpr size_t R_Z = 0, R_Y = 288 * MiB;
constexpr size_t R_H = 0;
constexpr size_t R_HM = 0, R_F = 231 * MiB;
constexpr size_t WS_END = WS_R + 491 * MiB;
constexpr size_t WS_NEED = WS_END;
constexpr int CW_TMO = 0, CW_CODE = 1;
constexpr int CW_BAR = 4096;
constexpr int CW_LNC = 20480;
constexpr int CW_CNT = 16384;
constexpr int RING_OFF = 0, RING_BYTES = 131072;
constexpr int ROWTAB_OFF = RING_BYTES;
constexpr int LNTAB_OFF = ROWTAB_OFF;
constexpr int RUEXP_OFF = ROWTAB_OFF + 29 * 512;
constexpr int LDSCTL_OFF = RUEXP_OFF + 1024, MISC_OFF = LDSCTL_OFF;
constexpr int LDS_BYTES = 147456;
static_assert(MISC_OFF + 256 <= LDS_BYTES, "LDS map");

#define GAS __attribute__((address_space(1)))
#define LAS __attribute__((address_space(3)))
typedef unsigned short bf16;
typedef unsigned v4u __attribute__((ext_vector_type(4)));
typedef unsigned v2u __attribute__((ext_vector_type(2)));
typedef float f32x4 __attribute__((ext_vector_type(4)));
typedef float f32x2 __attribute__((ext_vector_type(2)));
typedef GAS unsigned gu32;
#define RLX_AGENT __ATOMIC_RELAXED, __HIP_MEMORY_SCOPE_AGENT
#define LDS_WAIT() asm volatile("s_waitcnt lgkmcnt(0)" ::: "memory")
#define VM_WAIT() asm volatile("s_waitcnt vmcnt(0)" ::: "memory")
__device__ __forceinline__ unsigned f2bf(float f) { unsigned u = __builtin_bit_cast(unsigned, f); return (u + 0x7fffu + ((u >> 16) & 1u)) >> 16; }
__device__ __forceinline__ unsigned pk2(float lo, float hi) { unsigned r; asm("v_cvt_pk_bf16_f32 %0, %1, %2" : "=v"(r) : "v"(lo), "v"(hi)); return r; }
__device__ __forceinline__ float bf2f(unsigned short b) { return __builtin_bit_cast(float, (unsigned)b << 16); }
__device__ __forceinline__ float bflo(unsigned w) { return __builtin_bit_cast(float, w << 16); }
__device__ __forceinline__ float bfhi(unsigned w) { return __builtin_bit_cast(float, w & 0xffff0000u); }

#define XB_TMO      128
#define XB_XCNT(j)  (256  + 64 * (j))
#define XB_XSUB(j)  (1280 + 64 * (j))
#define XB_XGEN(j)  (2304 + 64 * (j))
#define XB_TOP      3328
#define XB_TOPGEN   3392
#define XCD_BAR_WORDS 3456
#define XB_SPIN_CAP (1u << 18)
__device__ __forceinline__ unsigned xb_ld(unsigned* p)              { return __hip_atomic_load(p, __ATOMIC_RELAXED, __HIP_MEMORY_SCOPE_AGENT); }
__device__ __forceinline__ unsigned xb_add(unsigned* p, unsigned v) { return __hip_atomic_fetch_add(p, v, __ATOMIC_RELAXED, __HIP_MEMORY_SCOPE_AGENT); }
__device__ __forceinline__ unsigned xb_xcc_id() { return (unsigned)__builtin_amdgcn_s_getreg((3 << 11) | 20) & 0xFu; }
#define XB_SPIN(cond, bar) do { unsigned _sp = 0; while (cond) { __builtin_amdgcn_s_sleep(1); \
    if ((++_sp & 255u) == 0u) { if (xb_ld(&(bar)[XB_TMO])) break; if (_sp > XB_SPIN_CAP) { atomicAdd(&(bar)[XB_TMO], 1u); break; } } } } while (0)
struct XcdBarrier { unsigned* bar; unsigned x; volatile LAS unsigned* st; };
__device__ __forceinline__ XcdBarrier xcd_barrier_post(unsigned* bar, volatile LAS unsigned* st) {
    XcdBarrier b; b.bar = bar; b.x = xb_xcc_id(); b.st = st;
    if (threadIdx.x == 0) (void)xb_add(&bar[XB_XCNT(b.x)], 1u);
    return b;
}
__device__ __forceinline__ void xcd_barrier_complete(unsigned* bar, unsigned x, unsigned& nloc, unsigned& nx) {
    const unsigned G = gridDim.x * gridDim.y * gridDim.z;
    unsigned sum, cnt, mine, sp = 0u;
    for (;;) {
        sum = 0u; cnt = 0u; mine = 0u;
#pragma unroll
        for (unsigned j = 0; j < 16; ++j) { const unsigned c = xb_ld(&bar[XB_XCNT(j)]); sum += c; cnt += (c > 0u) ? 1u : 0u; mine = (j == x) ? c : mine; }
        if (sum == G) break;
        __builtin_amdgcn_s_sleep(1);
        if ((++sp & 255u) == 0u) { if (xb_ld(&bar[XB_TMO])) break; if (sp > XB_SPIN_CAP) { atomicAdd(&bar[XB_TMO], 1u); break; } }
    }
    nloc = mine > 0u ? mine : 1u; nx = cnt > 0u ? cnt : 1u;
}
__device__ __forceinline__ void xcd_barrier(const XcdBarrier& b) {
    asm volatile("s_waitcnt vmcnt(0)" ::: "memory");
    __syncthreads();
    if (threadIdx.x == 0) {
        unsigned* bar = b.bar;
        __builtin_amdgcn_s_waitcnt(0);
        unsigned nloc = b.st[0], nx = b.st[1];
        if (nloc == 0u) { xcd_barrier_complete(bar, b.x, nloc, nx); b.st[0] = nloc; b.st[1] = nx; }
        const unsigned old = xb_add(&bar[XB_XSUB(b.x)], 1u);
        const unsigned gen = old / nloc;
        if (old + 1u == (gen + 1u) * nloc) {
            __builtin_amdgcn_fence(__ATOMIC_RELEASE, "agent");
            asm volatile("s_waitcnt vmcnt(0)" ::: "memory");
            const unsigned og = xb_add(&bar[XB_TOP], 1u);
            const unsigned tg = og / nx;
            if (og + 1u == (tg + 1u) * nx) xb_add(&bar[XB_TOPGEN], 1u);
            else XB_SPIN(xb_ld(&bar[XB_TOPGEN]) == tg, bar);
            __builtin_amdgcn_fence(__ATOMIC_ACQUIRE, "agent");
            xb_add(&bar[XB_XGEN(b.x)], 1u);
            asm volatile("s_waitcnt vmcnt(0)" ::: "memory");
        } else {
            XB_SPIN(xb_ld(&bar[XB_XGEN(b.x)]) == gen, bar);
            __builtin_amdgcn_fence(__ATOMIC_ACQUIRE, "agent");
            asm volatile("s_waitcnt vmcnt(0)" ::: "memory");
        }
    }
    __syncthreads();
}

struct Args {
    const float* x; const int* pos; const float* w_in; const float* w_o; const float* pool_w; const float* pool_scale; const float* sconv_w; const float* dlam; const float* subg;
    const float* conf_dw; const float* conf_g; const float* conf_b; const float* ln1_g; const float* ln1_b; const float* ln2_g; const float* ln2_b;
    const float* ffn_wg; const float* ffn_wu; const float* ffn_wd; const float* router; const float* moe_wg; const float* moe_wu; const float* moe_wd;
    float* out; unsigned char* ws; int ph_lo, ph_hi;
};
struct Frame { LAS unsigned char* lds; gu32* ctl; int tid, lane, wave, vcu, G; };

__device__ __forceinline__ float wave_sum(float v) {
#pragma unroll
    for (int o = 1; o < 64; o <<= 1) v += __shfl_xor(v, o);
    return v;
}

__device__ __forceinline__ void p0_transpose_item(const float* W, int K, int N, bf16* WT, int kb, int nb, int drow0, const float* poolw, const float* pools, LAS float* scr, int lane) {
    const int k0 = 64 * kb, n0 = 32 * nb;
    if (poolw) {
        const int n = n0 + (lane & 31), g = n >> 6, e = n & 63; const float sc = pools[n];
        for (int i = 0; i < 32; ++i) { const int kk = 2 * i + (lane >> 5); const float* wr = W + (size_t)(k0 + kk) * N + 64 * g; float a = 0.f;
            for (int c = 0; c < 64; ++c) a += wr[c] * poolw[(g * 64 + c) * 64 + e];
            scr[kk * 33 + (lane & 31)] = a * sc; }
    } else {
        const float* src = W + (size_t)(k0 + (lane >> 5)) * N + n0 + (lane & 31); float t[32];
#pragma unroll
        for (int i = 0; i < 32; ++i) t[i] = src[(size_t)(2 * i) * N];
#pragma unroll
        for (int i = 0; i < 32; ++i) scr[(2 * i + (lane >> 5)) * 33 + (lane & 31)] = t[i];
    }
    LDS_WAIT(); asm volatile("" ::: "memory");
    const int c = lane & 7;
#pragma unroll
    for (int j = 0; j < 4; ++j) { const int n = (lane >> 3) + 8 * j; const LAS float* s = scr + (8 * c) * 33 + n;
        v4u o; o.x = pk2(s[0 * 33], s[1 * 33]); o.y = pk2(s[2 * 33], s[3 * 33]); o.z = pk2(s[4 * 33], s[5 * 33]); o.w = pk2(s[6 * 33], s[7 * 33]);
        *(GAS v4u*)(WT + (size_t)(drow0 + n) * K + k0 + 8 * c) = o; }
    LDS_WAIT(); asm volatile("" ::: "memory");
}
__device__ __forceinline__ void p0_transpose_item8(const float* W, int K, int N, unsigned char* WT, int kb, int nb, int drow0, float scale, LAS float* scr, int lane) {
    const int k0 = 128 * kb, n0 = 32 * nb;
    const float* src = W + (size_t)(k0 + (lane >> 5)) * N + n0 + (lane & 31);
    float t[64];
#pragma unroll
    for (int i = 0; i < 64; ++i) t[i] = src[(size_t)(2 * i) * N];
#pragma unroll
    for (int i = 0; i < 64; ++i) scr[(2 * i + (lane >> 5)) * 33 + (lane & 31)] = t[i];
    LDS_WAIT(); asm volatile("" ::: "memory");
    const int c = lane & 7;
#pragma unroll
    for (int j = 0; j < 4; ++j) { const int n = (lane >> 3) + 8 * j; const LAS float* s = scr + (16 * c) * 33 + n; v4u o;
        o.x = pg8::pk_fp8x4(s[0 * 33] * scale, s[1 * 33] * scale, s[2 * 33] * scale, s[3 * 33] * scale); o.y = pg8::pk_fp8x4(s[4 * 33] * scale, s[5 * 33] * scale, s[6 * 33] * scale, s[7 * 33] * scale);
        o.z = pg8::pk_fp8x4(s[8 * 33] * scale, s[9 * 33] * scale, s[10 * 33] * scale, s[11 * 33] * scale); o.w = pg8::pk_fp8x4(s[12 * 33] * scale, s[13 * 33] * scale, s[14 * 33] * scale, s[15 * 33] * scale);
        *(GAS v4u*)(WT + (size_t)(drow0 + n) * K + k0 + 16 * c) = o; }
    LDS_WAIT(); asm volatile("" ::: "memory");
}
__device__ __forceinline__ int win_row(int n) {
    if (n >= 512 && n < 1024) { const int hv = n >= 768, i = n - (hv ? 768 : 512); return 512 + (i >> 7) * 256 + hv * 128 + (i & 127); }
    if (n >= 1792) { const int gt = n >= 2048, i = n - (gt ? 2048 : 1792); return 1792 + (i >> 7) * 256 + (gt ? 0 : 128) + (i & 127); }
    return n;
}
__device__ __forceinline__ void p0_prologue(const Args& a, Frame& F) {
    LAS float* scr = (LAS float*)(F.lds + RING_OFF + F.wave * 16896);
    const int gw = F.vcu * NWAVES + F.wave, NGW = F.G * NWAVES;
    unsigned char* ws = a.ws;
    constexpr int IA = 16 * 72, IB = 16 * 32, IC = 16 * 88, ID = 22 * 32, IE = 8 * 112, IF = 28 * 32, IG = 8 * 88;
    constexpr int NA = 4 * IA, NB = 4 * IB, NC = 4 * IC, ND = 2 * ID, NEI = 32 * IE, NF = 16 * IF, NG = 2 * IG;
    constexpr int NITEMS = NA + NB + NC + ND + NEI + NF + NG;
    for (int it = gw; it < NITEMS; it += NGW) {
        int r = it;
        if (r < NA) { const int l = r / IA, s = r % IA, kb = s / 72, nb = s % 72;
            p0_transpose_item(a.w_in + (size_t)l * D * NZ, D, NZ, (bf16*)(ws + WS_WIN) + (size_t)l * NZ * D, kb, nb, win_row(32 * nb), nb < 8 ? a.pool_w + (size_t)l * 4 * 64 * 64 : nullptr, a.pool_scale + l * 256, scr, F.lane); continue; } r -= NA;
        if (r < NB) { const int l = r / IB, s = r % IB, kb = s / 32, nb = s % 32;
            p0_transpose_item(a.w_o + (size_t)l * D * D, D, D, (bf16*)(ws + WS_WO) + (size_t)l * D * D, kb, nb, 32 * nb, nullptr, nullptr, scr, F.lane); continue; } r -= NB;
        if (r < NC) { const int q = r / IC, s = r % IC, j = q >> 1, up = q & 1, kb = s / 88, nb = s % 88; const int n0 = 32 * nb;
            if (j == 1 && gridDim.x == 256) continue;
            p0_transpose_item((up ? a.ffn_wu : a.ffn_wg) + (size_t)j * D * FF, D, FF, (bf16*)(ws + WS_WGU) + (size_t)j * NGU * D, kb, nb, (n0 >> 7) * 256 + (n0 & 127) + up * 128, nullptr, nullptr, scr, F.lane); continue; } r -= NC;
        if (r < ND) { const int j = r / ID, s = r % ID, kb = s / 32, nb = s % 32;
            p0_transpose_item8(a.ffn_wd + (size_t)j * FF * D, FF, D, ws + WS_WD + (size_t)j * D * FF, kb, nb, 32 * nb, WD_SCALE, scr, F.lane); continue; } r -= ND;
        if (r < NEI) { const int q = r / IE, s = r % IE, je = q >> 1, up = q & 1, kb = s / 112, nb = s % 112; const int n0 = 32 * nb;
            p0_transpose_item8((up ? a.moe_wu : a.moe_wg) + (size_t)je * D * FE, D, FE, ws + WS_MGU + (size_t)je * NGUE * D, kb, nb, (n0 >> 7) * 256 + (n0 & 127) + up * 128, W1_SCALE, scr, F.lane); continue; } r -= NEI;
        if (r < NF) { const int je = r / IF, s = r % IF, kb = s / 32, nb = s % 32;
            p0_transpose_item8(a.moe_wd + (size_t)je * FE * D, FE, D, ws + WS_MD + (size_t)je * D * FE, kb, nb, 32 * nb, WD_SCALE, scr, F.lane); continue; } r -= NF;
        { const int q = r / IG, s = r % IG, j = 1, up = q & 1, kb = s / 88, nb = s % 88; const int n0 = 32 * nb;
            p0_transpose_item8((up ? a.ffn_wu : a.ffn_wg) + (size_t)j * D * FF, D, FF, ws + WS_WGU8 + (size_t)j * NGU * D, kb, nb, (n0 >> 7) * 256 + (n0 & 127) + up * 128, W1_SCALE, scr, F.lane); }
    }
    bf16* XB = (bf16*)(ws + WS_XB);
    for (int m0 = gw * 4; m0 < M; m0 += NGW * 4) {
        f32x4 v[4][4];
#pragma unroll
        for (int r = 0; r < 4; ++r) { const GAS f32x4* xr = (const GAS f32x4*)(a.x + (size_t)(m0 + r) * D) + F.lane;
#pragma unroll
            for (int j = 0; j < 4; ++j) v[r][j] = xr[64 * j]; }
#pragma unroll
        for (int r = 0; r < 4; ++r) { GAS unsigned long long* o8 = (GAS unsigned long long*)(XB + (size_t)(m0 + r) * D) + F.lane;
#pragma unroll
            for (int j = 0; j < 4; ++j) o8[64 * j] = (unsigned long long)pk2(v[r][j].x, v[r][j].y) | ((unsigned long long)pk2(v[r][j].z, v[r][j].w) << 32); } }
    float* cosb = (float*)(ws + WS_ROPE); float* sinb = cosb + (size_t)M * 4;
    for (int i = (F.vcu * NWAVES + F.wave) * 64 + F.lane; i < M * 4; i += NGW * 64) { const int row = i >> 2, j = i & 3;
        const float inv = (j == 0) ? 1.0f : (j == 1) ? 0.037606030930863934f : (j == 2) ? 0.0014142135623730950f : 5.3183958501313043e-05f;
        const float ang = (float)a.pos[row] * inv; cosb[i] = (float)cos((double)ang); sinb[i] = (float)sin((double)ang); }
}

__device__ __forceinline__ void v8t_items(const Args& a, Frame& F) {
    const bf16* Z = (const bf16*)(a.ws + WS_R + R_Z); unsigned char* V8 = a.ws + WS_V8T;
    int tl = F.tid; asm volatile("" : "+v"(tl)); const int lane = tl & 63;
    LAS unsigned char* scr = F.lds + RING_OFF + F.wave * 4096;
    const int kk = lane & 31, hi = (kk >> 2) & 1, r = (kk & 3) + 4 * (kk >> 3), p = hi * 32 + (lane >> 5) * 16 + r;
    LAS unsigned char* wp = scr + (p >> 4) * 1024 + (p & 15);
    const int gw = F.vcu * NWAVES + F.wave, NGW = F.G * NWAVES;
    for (int it = gw; it < BATCH * 4 * 128; it += NGW) { const int bh = it >> 7, tile = it & 127, b = bh >> 2, h = bh & 3;
        const v4u* src = (const v4u*)(a.ws + WS_V8R + (size_t)(b * SEQ + tile * 64 + lane) * 256 + h * 64);
        v4u v[4];
#pragma unroll
        for (int i = 0; i < 4; ++i) v[i] = src[i];
#pragma unroll
        for (int i = 0; i < 4; ++i) { const unsigned w4[4] = {v[i].x, v[i].y, v[i].z, v[i].w};
#pragma unroll
            for (int d = 0; d < 4; ++d)
#pragma unroll
                for (int q = 0; q < 4; ++q) wp[(16 * i + 4 * d + q) * 16] = (unsigned char)(w4[d] >> (8 * q)); }
        LDS_WAIT(); asm volatile("" ::: "memory");
        unsigned char* dst = V8 + ((size_t)bh * 128 + tile) * 4096;
#pragma unroll
        for (int i = 0; i < 4; ++i) *(GAS v4u*)(dst + (i * 64 + lane) * 16) = *(const LAS v4u*)(scr + (i * 64 + lane) * 16);
        LDS_WAIT(); asm volatile("" ::: "memory");
    }
}

__device__ __forceinline__ unsigned pk2c(float lo, float hi) { unsigned r; asm("v_cvt_pk_bf16_f32 %0, %1, %2" : "=v"(r) : "v"(lo), "v"(hi)); return r; }
__device__ __forceinline__ unsigned mul_bf2(unsigned g, unsigned h) { return pk2c(bflo(g) * bflo(h), bfhi(g) * bfhi(h)); }
__device__ __forceinline__ float sigm(float x) { return __builtin_amdgcn_rcpf(1.0f + __builtin_amdgcn_exp2f(x * -1.4426950408889634f)); }
__device__ __forceinline__ unsigned glu_bf2(unsigned ca, unsigned cg) { return pk2c(bflo(ca) * sigm(bflo(cg)), bfhi(ca) * sigm(bfhi(cg))); }
__device__ __forceinline__ void mixer_items(const Args& a, Frame& F, int l, int item0, int stride) {
    const bf16* Z = (const bf16*)(a.ws + WS_R + R_Z); bf16* Y = (bf16*)(a.ws + WS_R + R_Y);
    const v4u zero4 = (v4u){0u, 0u, 0u, 0u};
#define MX_SYNC() asm volatile("s_waitcnt lgkmcnt(0)\n\ts_barrier" ::: "memory")
    v4u pin[5];
#define MX_LOAD_POOL(it_) do { int tq = F.tid; asm volatile("" : "+v"(tq)); const int t0q = (it_) * 64, s0q = t0q & (SEQ - 1); \
        _Pragma("unroll") for (int i = 0; i < 5; ++i) { const int c = tq + 512 * i, r = c >> 5, k = c & 31; pin[i] = zero4; if (c < 79 * 32 && s0q - 15 + r >= 0) pin[i] = *(const v4u*)(Z + (size_t)(t0q - 15 + r) * ZW + k * 8); } } while (0)
    float wdj[31]; { int tq = F.tid; asm volatile("" : "+v"(tq)); const float* wd = a.conf_dw + (size_t)l * 31 * 256 + (tq & 255);
#pragma unroll
        for (int j = 0; j < 31; ++j) wdj[j] = wd[j * 256]; }
    if (item0 < M / 64) MX_LOAD_POOL(item0);
    for (int item = item0; item < M / 64; item += stride) {
    int tl = F.tid; asm volatile("" : "+v"(tl));
    const int ch = tl & 255, rh = tl >> 8;
    const int t0 = item * 64, s0 = t0 & (SEQ - 1);
    LAS unsigned char* L = F.lds;
    LAS bf16* IN = (LAS bf16*)L; LAS bf16* OUTA = (LAS bf16*)(L + 40448); LAS bf16* P = (LAS bf16*)(L + 73216); LAS bf16* SBt = (LAS bf16*)(L + 107008);
    LAS bf16* OUTB = (LAS bf16*)L; LAS bf16* U = (LAS bf16*)(L + 32768); LAS float* cv = (LAS float*)(L + 80896);
#pragma unroll
    for (int i = 0; i < 5; ++i) { const int c = tl + 512 * i, r = c >> 5, k = c & 31; if (c < 79 * 32) *(LAS v4u*)(IN + r * 256 + k * 8) = pin[i]; }
    MX_SYNC();
    v4u sp[5], sbv[4];
#pragma unroll
    for (int i = 0; i < 5; ++i) { const int c = tl + 512 * i, r = c >> 5, k = c & 31; sp[i] = zero4;
        if (c < 66 * 32 && s0 - 2 + r >= 0) sp[i] = *(const v4u*)(Z + (size_t)(t0 - 2 + r) * ZW + 512 + k * 8); }
#pragma unroll
    for (int i = 0; i < 4; ++i) { const int c = tl + 512 * i, r = c >> 5, k = c & 31; sbv[i] = *(const v4u*)(Z + (size_t)(t0 + r) * ZW + 256 + k * 8); }
    {
        const int w = 2 << (ch >> 6); const LAS bf16* ic = IN + (rh * 32) * 256 + ch;
        float v[47];
#pragma unroll
        for (int i = 0; i < 47; ++i) v[i] = bf2f(ic[i * 256]);
        LAS bf16* oc = OUTA + (rh * 32) * 256 + ch; const int sb = s0 + rh * 32;
#define MX_POOL(W) do { float acc = 0.f; _Pragma("unroll") for (int j = 1; j < (W); ++j) acc += v[15 - j]; \
        _Pragma("unroll") for (int i = 0; i < 32; ++i) { const int s = sb + i; acc += v[15 + i]; \
            const float rc = (s + 1 < (W)) ? __builtin_amdgcn_rcpf((float)(s + 1)) : (1.0f / (float)(W)); const float ov = acc * rc - v[15 + i]; oc[i * 256] = (bf16)pk2c(ov, ov); \
            acc -= v[16 + i - (W)]; } } while (0)
        if (w == 2) MX_POOL(2); else if (w == 4) MX_POOL(4); else if (w == 8) MX_POOL(8); else MX_POOL(16);
#undef MX_POOL
    }
#pragma unroll
    for (int i = 0; i < 5; ++i) { const int c = tl + 512 * i, r = c >> 5, k = c & 31; if (c < 66 * 32) *(LAS v4u*)(P + r * 256 + k * 8) = sp[i]; }
#pragma unroll
    for (int i = 0; i < 4; ++i) { const int c = tl + 512 * i, r = c >> 5, k = c & 31; *(LAS v4u*)(SBt + r * 256 + k * 8) = sbv[i]; }
    MX_SYNC();
#pragma unroll
    for (int i = 0; i < 4; ++i) { const int c = tl + 512 * i, r = c >> 5, k = c & 31; *(v4u*)(Y + (size_t)(t0 + r) * D + k * 8) = *(const LAS v4u*)(OUTA + r * 256 + k * 8); }
    v4u cuv[6];
#pragma unroll
    for (int i = 0; i < 6; ++i) { const int c = tl + 512 * i, r = c >> 5, k = c & 31; cuv[i] = zero4;
        if (c < 94 * 32 && s0 - 30 + r >= 0) cuv[i] = *(const v4u*)(Z + (size_t)(t0 - 30 + r) * ZW + 1024 + k * 8); }
    {
        const float* wc = a.sconv_w + (size_t)l * 3 * 256 + ch; const float w0 = wc[0], w1 = wc[256], w2 = wc[512];
        const LAS bf16* pc = P + (rh * 32) * 256 + ch; const LAS bf16* sc = SBt + (rh * 32) * 256 + ch; LAS bf16* oc = OUTB + (rh * 32) * 256 + ch;
        float p[34];
#pragma unroll
        for (int i = 0; i < 34; ++i) p[i] = bf2f(pc[i * 256]);
#pragma unroll
        for (int i = 0; i < 32; ++i) { const float ov = bf2f(sc[i * 256]) * (w0 * p[i] + w1 * p[i + 1] + w2 * p[i + 2]); oc[i * 256] = (bf16)pk2c(ov, ov); }
    }
    MX_SYNC();
#pragma unroll
    for (int i = 0; i < 6; ++i) { const int c = tl + 512 * i, r = c >> 5, k = c & 31; if (c < 94 * 32) *(LAS v4u*)(U + r * 256 + k * 8) = cuv[i]; }
#pragma unroll
    for (int i = 0; i < 4; ++i) { const int c = tl + 512 * i, r = c >> 5, k = c & 31; *(v4u*)(Y + (size_t)(t0 + r) * D + 256 + k * 8) = *(const LAS v4u*)(OUTB + r * 256 + k * 8); }
    MX_SYNC();
    {
        const LAS bf16* uc = U + (rh * 32) * 256 + ch;
        if (item + stride < M / 64) MX_LOAD_POOL(item + stride);
        float u[62];
#pragma unroll
        for (int i = 0; i < 62; ++i) u[i] = bf2f(uc[i * 256]);
        float o[32];
#pragma unroll
        for (int i = 0; i < 32; ++i) o[i] = 0.f;
#pragma unroll
        for (int j = 0; j < 31; ++j) { const float wj = wdj[j];
#pragma unroll
            for (int i = 0; i < 32; ++i) o[i] += wj * u[i + j]; }
#pragma unroll
        for (int i = 0; i < 32; ++i) cv[(rh * 32 + i) * 256 + ch] = o[i];
        MX_SYNC();
        int ll = F.lane; asm volatile("" : "+v"(ll));
        const f32x4 gv = *(const f32x4*)(a.conf_g + l * 256 + 4 * ll), bv = *(const f32x4*)(a.conf_b + l * 256 + 4 * ll);
        f32x4 v8[8]; float s8[8], q8[8];
#pragma unroll
        for (int i = 0; i < 8; ++i) { v8[i] = *(const LAS f32x4*)(cv + (F.wave * 8 + i) * 256 + 4 * ll); const f32x4 v = v8[i];
            s8[i] = (v.x + v.y) + (v.z + v.w); q8[i] = (v.x * v.x + v.y * v.y) + (v.z * v.z + v.w * v.w); }
#pragma unroll
        for (int o = 1; o < 64; o <<= 1) {
#pragma unroll
            for (int i = 0; i < 8; ++i) { s8[i] += __shfl_xor(s8[i], o); q8[i] += __shfl_xor(q8[i], o); } }
#pragma unroll
        for (int i = 0; i < 8; ++i) { const int r = F.wave * 8 + i; const float mean = s8[i] * (1.f / 256.f); const float var = __builtin_fmaxf(q8[i] * (1.f / 256.f) - mean * mean, 0.f);
            const float rstd = __builtin_amdgcn_rsqf(var + LN_EPS);
            f32x4 y = (v8[i] - mean) * rstd * gv + bv;
#pragma unroll
            for (int q = 0; q < 4; ++q) y[q] = y[q] * sigm(y[q]);
            v2u o2; o2.x = pk2c(y.x, y.y); o2.y = pk2c(y.z, y.w);
            *(v2u*)(Y + (size_t)(t0 + r) * D + 768 + 4 * ll) = o2; }
        MX_SYNC();
    }
    }
#undef MX_LOAD_POOL
#undef MX_SYNC
}

__device__ __forceinline__ int moe_setup(Frame& F, int jmoe);
__device__ __forceinline__ void wave_sum4(float (&v)[4]) {
#pragma unroll
    for (int o = 1; o < 64; o <<= 1) {
#pragma unroll
        for (int r = 0; r < 4; ++r) v[r] += __shfl_xor(v[r], o); }
}
template <int MODE, bool FINAL>
__device__ __forceinline__ void ln_pass(const Args& a, Frame& F, const float* gam, const float* bet, int jmoe, int tile0) {
    bf16* XB = (bf16*)(a.ws + WS_XB);
    { int t_ = F.tid; asm volatile("" : "+v"(t_)); F.tid = t_; F.lane = t_ & 63; }
    LAS float* wr = (LAS float*)(F.lds + RING_OFF);
    LAS int* sel = (LAS int*)(F.lds + RING_OFF + 32768);
    int4* tok = (int4*)(a.ws + WS_TOK); int* list = (int*)(a.ws + WS_LIST);
    gu32* cnt = F.ctl + CW_CNT + jmoe * 8 * 64;
    const LAS int* ub = (const LAS int*)(F.lds + RUEXP_OFF + 640);
    if (MODE == 1) { const float* rw = a.router + (size_t)jmoe * D * NE;
        for (int i = F.tid; i < D * NE; i += NWAVES * 64) { const int col = i >> 3, e = i & 7, ln = (col & 255) >> 2, q = col & 3, j = col >> 8; wr[((((j * 4 + q) * 2 + (e >> 2)) * 64 + ln) << 2) + (e & 3)] = rw[i]; }
        __syncthreads(); }
    if (MODE == 2) { (void)moe_setup(F, jmoe); }
    f32x4 gv[4], bv[4];
#pragma unroll
    for (int j = 0; j < 4; ++j) { gv[j] = *(const f32x4*)(gam + 4 * F.lane + 256 * j); bv[j] = *(const f32x4*)(bet + 4 * F.lane + 256 * j); }
    const bf16* Fb = (const bf16*)(a.ws + WS_R + R_F);
    for (int tile = tile0; tile < M / 256; tile += F.G) {
        for (int rr = 0; rr < 32; rr += 4) {
            const int row0 = tile * 256 + F.wave * 32 + rr;
            f32x4 v[4][4];
#pragma unroll
            for (int r = 0; r < 4; ++r) { const GAS v2u* xr = (const GAS v2u*)(XB + (size_t)(row0 + r) * D) + F.lane;
#pragma unroll
                for (int j = 0; j < 4; ++j) { const v2u q = xr[64 * j]; v[r][j] = (f32x4){bflo(q.x), bfhi(q.x), bflo(q.y), bfhi(q.y)}; } }
            if (MODE == 2) {
                int4 ti[4];
#pragma unroll
                for (int r = 0; r < 4; ++r) ti[r] = tok[row0 + r];
#pragma unroll
                for (int r = 0; r < 4; ++r) { const float w1 = __builtin_bit_cast(float, ti[r].z), w2 = __builtin_bit_cast(float, ti[r].w);
                    const size_t p1 = (size_t)(ub[ti[r].x >> 16] * 256 + (ti[r].x & 0xffff)), p2 = (size_t)(ub[ti[r].y >> 16] * 256 + (ti[r].y & 0xffff));
                    const v2u* f1 = (const v2u*)(Fb + p1 * D) + F.lane; const v2u* f2 = (const v2u*)(Fb + p2 * D) + F.lane;
#pragma unroll
                    for (int j = 0; j < 4; ++j) { const v2u q1 = f1[64 * j], q2 = f2[64 * j];
                        v[r][j].x = DN_ALPHA * v[r][j].x + (w1 * bflo(q1.x) + w2 * bflo(q2.x)); v[r][j].y = DN_ALPHA * v[r][j].y + (w1 * bfhi(q1.x) + w2 * bfhi(q2.x));
                        v[r][j].z = DN_ALPHA * v[r][j].z + (w1 * bflo(q1.y) + w2 * bflo(q2.y)); v[r][j].w = DN_ALPHA * v[r][j].w + (w1 * bfhi(q1.y) + w2 * bfhi(q2.y)); } }
            }
            float s[4];
#pragma unroll
            for (int r = 0; r < 4; ++r) { s[r] = 0.f;
#pragma unroll
                for (int j = 0; j < 4; ++j) s[r] += (v[r][j].x + v[r][j].y) + (v[r][j].z + v[r][j].w); }
            wave_sum4(s);
            float s2[4];
#pragma unroll
            for (int r = 0; r < 4; ++r) { const float mean = s[r] * (1.f / D); s2[r] = 0.f;
#pragma unroll
                for (int j = 0; j < 4; ++j) { v[r][j] = v[r][j] - mean; s2[r] += (v[r][j].x * v[r][j].x + v[r][j].y * v[r][j].y) + (v[r][j].z * v[r][j].z + v[r][j].w * v[r][j].w); } }
            wave_sum4(s2);
#pragma unroll
            for (int r = 0; r < 4; ++r) { const float rstd = __builtin_amdgcn_rsqf(s2[r] * (1.f / D) + LN_EPS);
                GAS f32x4* xr = (GAS f32x4*)(a.out + (size_t)(row0 + r) * D) + F.lane; GAS unsigned long long* o8 = (GAS unsigned long long*)(XB + (size_t)(row0 + r) * D) + F.lane;
#pragma unroll
                for (int j = 0; j < 4; ++j) { v[r][j] = v[r][j] * rstd * gv[j] + bv[j]; if (FINAL) xr[64 * j] = v[r][j]; else o8[64 * j] = (unsigned long long)pk2(v[r][j].x, v[r][j].y) | ((unsigned long long)pk2(v[r][j].z, v[r][j].w) << 32);
                    if (MODE == 1) ((GAS unsigned*)(a.ws + WS_XB8 + (size_t)(row0 + r) * D))[F.lane + 64 * j] = (unsigned)__builtin_amdgcn_cvt_pk_fp8_f32(v[r][j].z, v[r][j].w, __builtin_amdgcn_cvt_pk_fp8_f32(v[r][j].x, v[r][j].y, 0, false), true); } }
            if (MODE == 1) {
#pragma unroll
                for (int r = 0; r < 4; ++r) {
                    float lg[NE];
#pragma unroll
                    for (int e = 0; e < NE; ++e) lg[e] = 0.f;
#pragma unroll
                    for (int j = 0; j < 4; ++j)
#pragma unroll
                        for (int q = 0; q < 4; ++q) { const LAS f32x4* w4 = (const LAS f32x4*)wr + ((j * 4 + q) * 2) * 64 + F.lane; const f32x4 wa = w4[0], wb = w4[64]; const float xv = v[r][j][q];
                            lg[0] += xv * wa.x; lg[1] += xv * wa.y; lg[2] += xv * wa.z; lg[3] += xv * wa.w; lg[4] += xv * wb.x; lg[5] += xv * wb.y; lg[6] += xv * wb.z; lg[7] += xv * wb.w; }
                    float h4[4], h2[2], h1;
                    { const bool up = (F.lane & 32) != 0;
#pragma unroll
                      for (int e = 0; e < 4; ++e) { const float keep = up ? lg[e + 4] : lg[e], give = up ? lg[e] : lg[e + 4]; h4[e] = keep + __shfl_xor(give, 32); } }
                    { const bool up = (F.lane & 16) != 0;
#pragma unroll
                      for (int e = 0; e < 2; ++e) { const float keep = up ? h4[e + 2] : h4[e], give = up ? h4[e] : h4[e + 2]; h2[e] = keep + __shfl_xor(give, 16); } }
                    { const bool up = (F.lane & 8) != 0; const float keep = up ? h2[1] : h2[0], give = up ? h2[0] : h2[1]; h1 = keep + __shfl_xor(give, 8); }
                    h1 += __shfl_xor(h1, 4); h1 += __shfl_xor(h1, 2); h1 += __shfl_xor(h1, 1);
                    float le[NE];
#pragma unroll
                    for (int e = 0; e < NE; ++e) le[e] = __builtin_bit_cast(float, __builtin_amdgcn_readlane(__builtin_bit_cast(int, h1), e * 8));
                    int i1 = 0; float m1 = le[0];
#pragma unroll
                    for (int e = 1; e < NE; ++e) if (le[e] > m1) { m1 = le[e]; i1 = e; }
                    int i2 = -1; float m2 = -INFINITY;
#pragma unroll
                    for (int e = 0; e < NE; ++e) if (e != i1 && (i2 < 0 || le[e] > m2)) { m2 = le[e]; i2 = e; }
                    const float w1 = 1.0f / (1.0f + expf(m2 - m1)), w2 = 1.0f - w1;
                    if (F.lane == 0) { LAS int* sp = sel + (F.wave * 32 + rr + r) * 4; sp[0] = i1; sp[1] = i2; sp[2] = __builtin_bit_cast(int, w1); sp[3] = __builtin_bit_cast(int, w2); }
                }
            }
        }
        if (MODE == 1) {
            __syncthreads();
            if (F.tid < 256) {
                const int token = tile * 256 + F.tid; const LAS int* sp = sel + F.tid * 4; const int e1 = sp[0], e2 = sp[1]; int slot1 = 0, slot2 = 0;
#pragma unroll
                for (int e = 0; e < NE; ++e) {
                    const bool mine = (e1 == e) || (e2 == e); const unsigned long long mk = __ballot(mine);
                    if (mk != 0ull) { const int leader = __builtin_ctzll(mk); unsigned base = 0u;
                        if (F.lane == leader) base = __hip_atomic_fetch_add(cnt + e * 64, (unsigned)__builtin_popcountll(mk), RLX_AGENT);
                        base = (unsigned)__shfl((int)base, leader);
                        const int my = (int)base + __builtin_popcountll(mk & ((1ull << F.lane) - 1ull));
                        if (e1 == e) slot1 = my; if (e2 == e) slot2 = my; }
                }
                list[e1 * M + slot1] = token; list[e2 * M + slot2] = token;
                tok[token] = make_int4((e1 << 16) | slot1, (e2 << 16) | slot2, sp[2], sp[3]);
            }
            __syncthreads();
        }
    }
}

__device__ __forceinline__ void xb8_pass(const Args& a, Frame& F) {
    { int t_ = F.tid; asm volatile("" : "+v"(t_)); F.tid = t_; F.lane = t_ & 63; }
    const bf16* XB = (const bf16*)(a.ws + WS_XB); unsigned char* X8 = a.ws + WS_XB8;
    const int gw = F.vcu * NWAVES + F.wave, NGW = F.G * NWAVES;
    for (int m0 = gw * 4; m0 < M; m0 += NGW * 4) {
        v2u q[4][4];
#pragma unroll
        for (int r = 0; r < 4; ++r) { const GAS v2u* xr = (const GAS v2u*)(XB + (size_t)(m0 + r) * D) + F.lane;
#pragma unroll
            for (int j = 0; j < 4; ++j) q[r][j] = xr[64 * j]; }
#pragma unroll
        for (int r = 0; r < 4; ++r)
#pragma unroll
            for (int j = 0; j < 4; ++j) ((GAS unsigned*)(X8 + (size_t)(m0 + r) * D))[F.lane + 64 * j] =
                (unsigned)__builtin_amdgcn_cvt_pk_fp8_f32(bflo(q[r][j].y), bfhi(q[r][j].y), __builtin_amdgcn_cvt_pk_fp8_f32(bflo(q[r][j].x), bfhi(q[r][j].x), 0, false), true);
    }
}
template <bool GATHER_> struct MoeOrder {
    static constexpr bool GATHER = GATHER_;
    int nru, nN, G, c, ru0, split, skip, ns; const LAS unsigned char* ruexp; const LAS unsigned short* rowtab;
    __device__ __forceinline__ int ru(int pm) const { return ru0 + pm + (pm >= split ? skip : 0); }
    __device__ __forceinline__ bool next(int i, pg8::Unit& u) const { int pm, pn; int cc = c, ii = i;
        if (ns > 0) { if (c < ns) { if (i >= 25) return false; } else if (c < 4 * ns && i == 28) { const int d = c - ns; cc = d % ns; ii = 25 + d / ns; } }
        if (!pg8::static_unit(nru, nN, G, cc, ii, pm, pn)) return false;
        const int e = __builtin_amdgcn_readfirstlane((int)ruexp[ru(pm)]); u.pm = pm; u.pn = pn; u.pb = e * nN + pn; return true; }
    __device__ __forceinline__ unsigned a_row(int ui, const pg8::Unit& u, int r) const { return GATHER_ ? (unsigned)rowtab[ui * 256 + r] : (unsigned)(u.pm * 256 + r); }
};
__device__ __forceinline__ int moe_setup(Frame& F, int jmoe) {
    gu32* cnt = F.ctl + CW_CNT + jmoe * 8 * 64; LAS unsigned char* ruexp = (LAS unsigned char*)(F.lds + RUEXP_OFF); LAS int* ub = (LAS int*)(F.lds + RUEXP_OFF + 640); LAS int* cn = ub + 8;
    int ubase[NE]; int acc = 0;
#pragma unroll
    for (int e = 0; e < NE; ++e) { const unsigned c = __hip_atomic_load(cnt + e * 64, RLX_AGENT); ubase[e] = acc; acc += (int)((c + 255u) >> 8); if (F.tid == 0) { ub[e] = ubase[e]; cn[e] = (int)c; } }
    const int U = acc < MOE_MAXU ? acc : MOE_MAXU;
    for (int ru = F.tid; ru < 640; ru += NWAVES * 64) { int e = 0;
#pragma unroll
        for (int q = 1; q < NE; ++q) if (ru >= ubase[q]) e = q;
        ruexp[ru] = (unsigned char)e; }
    __syncthreads();
    return U;
}
constexpr int STEPS_PER_LAYER = 6 + MOE_SEAMS;
constexpr int NSTEPS = 1 + DEPTH * STEPS_PER_LAYER;
#ifndef UP8_MASK
#define UP8_MASK 4
#endif
__device__ __forceinline__ float lam_init_of(int l) { return l == 0 ? 0.2f : l == 1 ? 0.35550906759096926f : l == 2 ? 0.47071301834358416f : 0.5560582041556405f; }

typedef const __attribute__((address_space(4))) Args* kargs_t;
#if defined(__HIP_DEVICE_COMPILE__)
__device__ __forceinline__ Args load_args(kargs_t p) { asm volatile("" : "+s"(p)); return *p; }
#else
__device__ __forceinline__ Args load_args(kargs_t) { return Args{}; }
#endif
__device__ __forceinline__ Frame make_frame(unsigned char* lds, unsigned char* ws) {
    Frame F; F.lds = (LAS unsigned char*)lds; F.tid = threadIdx.x; F.lane = F.tid & 63; F.wave = __builtin_amdgcn_readfirstlane(F.tid >> 6);
    F.G = gridDim.x; { const int bx = blockIdx.x; F.vcu = (F.G % 8 == 0) ? (bx % 8) * (F.G / 8) + bx / 8 : bx; }
    F.ctl = (gu32*)(ws + WS_CTL); return F;
}
__global__ void __launch_bounds__(NWAVES * 64, 2) fwd(Args a_in) {
    extern __shared__ __attribute__((aligned(16))) unsigned char lds[];
    const kargs_t ap = (kargs_t)__builtin_amdgcn_kernarg_segment_ptr();
    volatile LAS unsigned* MISC = (volatile LAS unsigned*)((LAS unsigned char*)lds + MISC_OFF);
    for (int u = threadIdx.x; u < 64; u += NWAVES * 64) MISC[u] = 0u;
    __syncthreads();
    const int lo = a_in.ph_lo, hi = a_in.ph_hi;
    if (hi - lo > 1) { (void)xcd_barrier_post((unsigned*)(a_in.ws + WS_CTL) + CW_BAR, MISC + 8); }
    int step = 0;
    const bool fuse_ln = (gridDim.x == 256);
#define IN() (lo <= step && step < hi)
#define SEAM() do { if (lo <= step && step + 1 < hi) { XcdBarrier bar_; bar_.bar = (unsigned*)(load_args(ap).ws + WS_CTL) + CW_BAR; bar_.x = xb_xcc_id(); bar_.st = MISC + 8; xcd_barrier(bar_); } ++step; } while (0)
#define SITE() const Args a = load_args(ap); unsigned char* ws = a.ws; Frame F = make_frame(lds, ws); LAS unsigned char* ring = F.lds + RING_OFF; const int cblk = (int)blockIdx.x; \
    bf16* XB = (bf16*)(ws + WS_XB); bf16* Zb = (bf16*)(ws + WS_R + R_Z); bf16* Yb = (bf16*)(ws + WS_R + R_Y); bf16* Hb = (bf16*)(ws + WS_R + R_H); bf16* HM = (bf16*)(ws + WS_R + R_HM); bf16* Fb = (bf16*)(ws + WS_R + R_F); \
    const float* cosb = (const float*)(ws + WS_ROPE); const float* sinb = cosb + (size_t)M * 4; (void)XB; (void)Zb; (void)Yb; (void)Hb; (void)HM; (void)Fb; (void)cosb; (void)sinb; (void)ring; (void)cblk

    if (IN()) { SITE(); p0_prologue(a, F);
    }
    SEAM();

    for (int l = 0; l < DEPTH; ++l) {
        const int jh = l >> 1; const bool moe = (l & 1) != 0;
        const bool up8 = fuse_ln && !moe && ((UP8_MASK >> l) & 1);
        if (IN()) { SITE();
            pg8::Gemm g{XB, (const bf16*)(ws + WS_WIN) + (size_t)l * NZ * D, D}; pg8::StaticOrder S{M / 256, NZ / 256, F.G, cblk};
            pg8::EpiZ E{Zb, ZW, cosb, sinb, attn_body::C2, ws + WS_V8R, ws + WS_KT};
            pg8::gemm_phase<pg8::EpiZ, pg8::StaticOrder>(ring, g, S, E);
        }
        SEAM();
        if (IN()) { SITE();
            v8t_items(a, F); __syncthreads();
            mixer_items(a, F, l, F.vcu, F.G);
        }
        SEAM();
        if (IN()) { SITE();
            float lam;
            { const float* lp = a.dlam + l * 128; float p1 = 0.f, p2 = 0.f; if (F.lane < 32) { p1 = lp[F.lane] * lp[32 + F.lane]; p2 = lp[64 + F.lane] * lp[96 + F.lane]; }
              lam = expf(wave_sum(p1)) - expf(wave_sum(p2)) + lam_init_of(l); }
            attn_body::AttnParams P{(const attn_body::bf16*)Zb, (attn_body::bf16*)Yb, lam, 1.0f - lam_init_of(l), a.subg + l * 64, ws + WS_V8T, ws + WS_KT};
            attn_body::attn_phase<4>((char*)lds + RING_OFF, P, F.vcu, F.G);
        }
        SEAM();
        if (IN()) { SITE();
            pg8::Gemm g{Yb, (const bf16*)(ws + WS_WO) + (size_t)l * D * D, D}; pg8::StaticOrder S{M / 256, D / 256, F.G, cblk};
            if (fuse_ln && !moe) {
                pg8::EpiResLN E{XB, D, DN_ALPHA, 1.f, a.ln1_g + l * D, a.ln1_b + l * D, (unsigned long long*)(ws + WS_XLN), (unsigned*)(ws + WS_CTL) + CW_LNC, 32u * (unsigned)(2 * jh + 1), (unsigned*)(ws + WS_CTL) + CW_TMO, F.lds + LNTAB_OFF};
                pg8::gemm_phase<pg8::EpiResLN, pg8::StaticOrder>(ring, g, S, E);
            } else {
                pg8::EpiRes E{XB, D, DN_ALPHA, 1.f};
                pg8::gemm_phase<pg8::EpiRes, pg8::StaticOrder>(ring, g, S, E);
            }
        }
        SEAM();
        if (moe || !fuse_ln) {
            if (IN()) { SITE(); if (moe) ln_pass<1, false>(a, F, a.ln1_g + l * D, a.ln1_b + l * D, jh, F.vcu);
                else ln_pass<0, false>(a, F, a.ln1_g + l * D, a.ln1_b + l * D, jh, F.vcu); }
            SEAM();
        } else if (up8) { if (IN()) { SITE(); xb8_pass(a, F); } SEAM(); }
        else ++step;
        if (!moe) {
            if (up8) { if (IN()) { SITE();
                pg8::StaticOrder S{M / 256, NGU / 256, F.G, cblk};
                pg8::Gemm g{(const bf16*)(ws + WS_XB8), (const bf16*)(ws + WS_WGU8 + (size_t)jh * NGU * D), D};
                pg8::EpiSwiGLU8 E{(unsigned char*)Hb, FF, 1.f / W1_SCALE, H_SCALE};
                pg8::gemm_phase<pg8::EpiSwiGLU8, pg8::StaticOrder, true>(ring, g, S, E); } }
            else { if (IN()) { SITE();
                pg8::StaticOrder S{M / 256, NGU / 256, F.G, cblk};
                pg8::Gemm g{XB, (const bf16*)(ws + WS_WGU) + (size_t)jh * NGU * D, D};
                pg8::EpiSwiGLU8 E{(unsigned char*)Hb, FF, 1.f, H_SCALE};
                pg8::gemm_phase<pg8::EpiSwiGLU8, pg8::StaticOrder>(ring, g, S, E); } }
            SEAM();
            if (IN()) { SITE();
                pg8::Gemm g{Hb, (const bf16*)(ws + WS_WD + (size_t)jh * D * FF), FF}; pg8::StaticOrder S{M / 256, D / 256, F.G, cblk};
                if (fuse_ln) {
                    pg8::EpiResLN E{XB, D, DN_ALPHA, 1.f / (H_SCALE * WD_SCALE), a.ln2_g + l * D, a.ln2_b + l * D, (unsigned long long*)(ws + WS_XLN), (unsigned*)(ws + WS_CTL) + CW_LNC, 32u * (unsigned)(2 * jh + 2), (unsigned*)(ws + WS_CTL) + CW_TMO, F.lds + LNTAB_OFF};
                    pg8::gemm_phase<pg8::EpiResLN, pg8::StaticOrder, true>(ring, g, S, E);
                } else {
                    pg8::EpiRes E{XB, D, DN_ALPHA, 1.f / (H_SCALE * WD_SCALE)};
                    pg8::gemm_phase<pg8::EpiRes, pg8::StaticOrder, true>(ring, g, S, E);
                }
            }
            SEAM();
            step += MOE_SEAMS - 2;
        } else {
#pragma nounroll
            for (int k = 0; k < 5; ++k) {
                const bool isup = (k == 0 || k == 2);
                if (isup) {
                    if (IN()) { SITE();
                        const int U = moe_setup(F, jh); const int rem = U - 2 * MOE_CH;
                        const LAS unsigned char* ruexp = (const LAS unsigned char*)(F.lds + RUEXP_OFF); const LAS int* ub = (const LAS int*)(F.lds + RUEXP_OFF + 640); const LAS int* cn = ub + 8;
                        LAS unsigned short* rowtab = (LAS unsigned short*)(F.lds + ROWTAB_OFF); const int* list = (const int*)(ws + WS_LIST);
                        MoeOrder<true> S{k == 0 ? MOE_CH + rem : MOE_CH, NGUE / 256, F.G, cblk, k == 0 ? 0 : MOE_CH, k == 0 ? MOE_CH : (1 << 30), k == 0 ? MOE_CH : 0, (k == 2 && F.G == 256) ? 4 * rem : 0, ruexp, rowtab};
                        for (int ui = 0; ui < 29; ++ui) { pg8::Unit u; if (!S.next(ui, u)) break;
                            if (F.tid < 256) { const int ru = S.ru(u.pm), e = (int)ruexp[ru], jj = (ru - ub[e]) * 256 + F.tid; rowtab[ui * 256 + F.tid] = (unsigned short)((jj < cn[e]) ? list[(size_t)e * M + jj] : 0); } }
                        __syncthreads();
                        pg8::Gemm g{(const bf16*)(ws + WS_XB8), (const bf16*)(ws + WS_MGU + (size_t)jh * NE * NGUE * D), D};
                        pg8::EpiSwiGLU8 E{(unsigned char*)HM, FE, 1.f / W1_SCALE, H_SCALE};
                        pg8::gemm_phase<pg8::EpiSwiGLU8, MoeOrder<true>, true>(ring, g, S, E);
                    }
                    if (k == 0) SEAM();
                } else {
                    if (IN()) { SITE();
                        const int U = moe_setup(F, jh); const int rem = U - 2 * MOE_CH;
                        const int nru = (k == 3) ? rem : MOE_CH; const int ru0 = (k == 1) ? 0 : (k == 3) ? 2 * MOE_CH : MOE_CH; const int hrow0 = (k == 3) ? MOE_CH * 256 : 0;
                        if (nru > 0) {
                            const LAS unsigned char* ruexp = (const LAS unsigned char*)(F.lds + RUEXP_OFF); const LAS unsigned short* rowtab = (const LAS unsigned short*)(F.lds + ROWTAB_OFF);
                            MoeOrder<false> S{nru, D / 256, F.G, cblk, ru0, (1 << 30), 0, 0, ruexp, rowtab};
                            pg8::Gemm g{(const bf16*)((const unsigned char*)HM + (size_t)hrow0 * FE), (const bf16*)(ws + WS_MD + (size_t)jh * NE * D * FE), FE};
                            pg8::EpiBf<false> E{Fb, D, ru0 * 256, nullptr, nullptr, -1, -1, 1.f, 1.f / (H_SCALE * WD_SCALE)};
                            pg8::gemm_phase<pg8::EpiBf<false>, MoeOrder<false>, true>(ring, g, S, E);
                        }
                    }
                    SEAM();
                }
            }
        }
        if (!moe && fuse_ln) { ++step; continue; }
        if (IN()) { SITE(); if (!moe) ln_pass<0, false>(a, F, a.ln2_g + l * D, a.ln2_b + l * D, jh, F.vcu); else if (l == DEPTH - 1) ln_pass<2, true>(a, F, a.ln2_g + l * D, a.ln2_b + l * D, jh, F.vcu); else ln_pass<2, false>(a, F, a.ln2_g + l * D, a.ln2_b + l * D, jh, F.vcu); }
        SEAM();
    }
#undef IN
#undef SEAM
#undef SITE
}
extern "C" void kernel_launch(void* const* d_in, const int* in_sizes, int n_in, void* d_out, int out_size, void* d_ws, size_t ws_size, hipStream_t stream) {
    static int grid = 0;
    if (grid == 0) {
        if (n_in != 23 || in_sizes[0] != M * D || out_size != M * D || ws_size < WS_NEED) { fprintf(stderr, "kernel_launch: unexpected shapes / workspace (n_in %d, ws %zu, need %zu); nothing launched\n", n_in, ws_size, (size_t)WS_NEED); grid = -1; return; }
        int dev = 0, cus = 0, per_cu = 0;
        if (hipGetDevice(&dev) != hipSuccess || hipDeviceGetAttribute(&cus, hipDeviceAttributeMultiprocessorCount, dev) != hipSuccess) { grid = -1; return; }
        if (hipFuncSetAttribute((const void*)fwd, hipFuncAttributeMaxDynamicSharedMemorySize, LDS_BYTES) != hipSuccess) { fprintf(stderr, "kernel_launch: hipFuncSetAttribute failed\n"); grid = -1; return; }
        if (hipOccupancyMaxActiveBlocksPerMultiprocessor(&per_cu, (const void*)fwd, NWAVES * 64, LDS_BYTES) != hipSuccess || per_cu < 1) fprintf(stderr, "kernel_launch: occupancy query says %d\n", per_cu);
        (void)hipGetLastError();
        grid = cus;
    }
    if (grid < 0) return;
    (void)hipMemsetAsync((char*)d_ws + WS_CTL, 0, CTL_ZERO_BYTES, stream);
    Args a{};
    a.x = (const float*)d_in[0]; a.pos = (const int*)d_in[1]; a.w_in = (const float*)d_in[2]; a.w_o = (const float*)d_in[3]; a.pool_w = (const float*)d_in[4]; a.pool_scale = (const float*)d_in[5];
    a.sconv_w = (const float*)d_in[6]; a.dlam = (const float*)d_in[7]; a.subg = (const float*)d_in[8]; a.conf_dw = (const float*)d_in[9]; a.conf_g = (const float*)d_in[10]; a.conf_b = (const float*)d_in[11];
    a.ln1_g = (const float*)d_in[12]; a.ln1_b = (const float*)d_in[13]; a.ln2_g = (const float*)d_in[14]; a.ln2_b = (const float*)d_in[15];
    a.ffn_wg = (const float*)d_in[16]; a.ffn_wu = (const float*)d_in[17]; a.ffn_wd = (const float*)d_in[18]; a.router = (const float*)d_in[19];
    a.moe_wg = (const float*)d_in[20]; a.moe_wu = (const float*)d_in[21]; a.moe_wd = (const float*)d_in[22];
    a.out = (float*)d_out; a.ws = (unsigned char*)d_ws;
    a.ph_lo = 0; a.ph_hi = NSTEPS;
    hipLaunchKernelGGL(fwd, dim3(grid), dim3(NWAVES * 64), LDS_BYTES, stream, a);
}
```

```cpp
#include <hip/hip_runtime.h>
#include <hip/hip_bf16.h>
#include <cstdio>
#include <cstdint>
#include <cmath>

#ifndef PG8_ASM_DMA_ALL
#define PG8_ASM_DMA_ALL true
#endif
namespace pg8 {
#define PG8_LAS __attribute__((address_space(3)))
typedef unsigned short bf16_t;
typedef short bf16x8 __attribute__((ext_vector_type(8)));
typedef float f32x4 __attribute__((ext_vector_type(4)));
typedef float f32x2 __attribute__((ext_vector_type(2)));
typedef unsigned u32x4 __attribute__((ext_vector_type(4)));
typedef unsigned u32x2 __attribute__((ext_vector_type(2)));
typedef int v4i_t __attribute__((ext_vector_type(4)));
typedef int v8i_t __attribute__((ext_vector_type(8)));
constexpr int BM = 256, BK = 64, HALF = 128, HTB = HALF * BK * 2, STAGE_BYTES = 8 * HTB, NXCD = 8, WGM = 8;

__host__ __device__ __forceinline__ int lds_byte(int r, int c) { const int st = (r >> 4) * 2 + (c >> 5), rr = r & 15, cc = c & 31, ob = rr * 64 + cc * 2; return st * 1024 + (ob ^ (((ob >> 9) & 1) << 5)); }
__host__ __device__ __forceinline__ void stage_rc(int b, int& R, int& C) { const int st = b / 1024, sb = b % 1024, swz = sb ^ (((sb >> 9) & 1) << 5); R = (st >> 1) * 16 + swz / 64; C = (st & 1) * 32 + (swz % 64) / 2; }
__host__ __device__ __forceinline__ int perm32(int rho) { const int n = rho >> 4, i = rho & 15; return 8 * (i >> 2) + 4 * n + (i & 3); }

struct Unit { int pm, pn, pb; };
struct Gemm { const bf16_t* A; const bf16_t* Bt; int K; };

__device__ __forceinline__ bool static_unit(int nM, int nN, int G, int c, int i, int& pm, int& pn) {
    const int nwg = nM * nN; const long L = (long)i * G + c; if (L >= nwg) return false;
    int wgid = (int)L; { const int q = nwg / NXCD, r = nwg % NXCD, xcd = wgid % NXCD, off = wgid / NXCD; wgid = (xcd < r ? xcd * (q + 1) : r * (q + 1) + (xcd - r) * q) + off; }
    const int nig = WGM * nN, gid = wgid / nig, fm = gid * WGM, gsz = (nM - fm) < WGM ? (nM - fm) : WGM;
    pm = fm + ((wgid % nig) % gsz); pn = (wgid % nig) / gsz; return true;
}
struct StaticOrder {
    static constexpr bool GATHER = false;
    int nM, nN, G, c;
    __device__ __forceinline__ bool next(int i, Unit& u) const { int pm, pn; if (!static_unit(nM, nN, G, c, i, pm, pn)) return false; u.pm = pm; u.pn = pn; u.pb = pn; return true; }
    __device__ __forceinline__ unsigned a_row(int, const Unit& u, int r) const { return (unsigned)(u.pm * BM + r); }
};

struct PanelOrder {
    static constexpr bool GATHER = false;
    int nM, nN, G, c;
    __device__ __forceinline__ bool next(int i, Unit& u) const { const int p = c + (i / nN) * G; if (p >= nM) return false; u.pm = p; u.pn = i % nN; u.pb = u.pn; return true; }
    __device__ __forceinline__ unsigned a_row(int, const Unit& u, int r) const { return (unsigned)(u.pm * BM + r); }
};
__device__ __forceinline__ unsigned cvt_pk_bf16(float lo, float hi) { unsigned r; asm volatile("v_cvt_pk_bf16_f32 %0, %1, %2" : "=v"(r) : "v"(lo), "v"(hi)); return r; }

template <bool ROPE> struct EpiBf {
    static constexpr bool PERM = true;
    bf16_t* O; int ldc; int row_off; const float* cosb; const float* sinb; int rope_q, rope_k; float qscale; float oscale;
    __device__ __forceinline__ void operator()(const f32x4 (&acc)[2][2][4][2], const Unit& u, int wr, int wc, int fr, int fq) const {
        const int row0 = row_off + u.pm * BM + wr * 64 + fr; const int col0 = u.pn * BM + wc * 32 + 8 * fq;
        const int mode = !ROPE ? 0 : (u.pn == rope_q) ? 2 : (u.pn == rope_k) ? 1 : 0;
#pragma unroll
        for (int ai = 0; ai < 2; ++ai)
#pragma unroll
            for (int m = 0; m < 4; ++m) { const int row = row0 + ai * HALF + m * 16; bf16_t* rowp = O + (size_t)row * ldc + col0;
                f32x4 cs = (f32x4){1.f, 1.f, 1.f, 1.f}, sn = (f32x4){0.f, 0.f, 0.f, 0.f};
                if (ROPE && mode != 0 && fq == 0) { cs = *(const f32x4*)(cosb + (size_t)row * 4); sn = *(const f32x4*)(sinb + (size_t)row * 4); }
#pragma unroll
                for (int bj = 0; bj < 2; ++bj) { f32x4 v0 = acc[ai][bj][m][0], v1 = acc[ai][bj][m][1]; if (oscale != 1.f) { v0 = v0 * oscale; v1 = v1 * oscale; }
                    if (ROPE && mode != 0) { const f32x4 r0 = v0 * cs - v1 * sn, r1 = v1 * cs + v0 * sn; v0 = r0; v1 = r1; if (mode == 2) { v0 = v0 * qscale; v1 = v1 * qscale; } }
                    u32x4 w; w.x = cvt_pk_bf16(v0[0], v0[1]); w.y = cvt_pk_bf16(v0[2], v0[3]); w.z = cvt_pk_bf16(v1[0], v1[1]); w.w = cvt_pk_bf16(v1[2], v1[3]);
                    *(u32x4*)(rowp + bj * HALF) = w; } }
    }
};
struct EpiZ {
    static constexpr bool PERM = true;
    bf16_t* O; int ldc; const float* cosb; const float* sinb; float qscale; unsigned char* V8; unsigned char* KT;
    __device__ __forceinline__ void operator()(const f32x4 (&acc)[2][2][4][2], const Unit& u, int wr, int wc, int fr, int fq) const {
        const int row0 = u.pm * BM + wr * 64 + fr;
        const int pn = u.pn;
        if (pn == 6) {
#pragma unroll
            for (int ai = 0; ai < 2; ++ai)
#pragma unroll
                for (int m = 0; m < 4; ++m) { const int row = row0 + ai * HALF + m * 16; const int b_ = row >> 13, s_ = row & 8191, tl_ = s_ >> 6, ky_ = s_ & 63, kk_ = ky_ & 31;
                    const int p_ = ((kk_ >> 2) & 1) * 32 + (ky_ >> 5) * 16 + (kk_ & 3) + 4 * (kk_ >> 3);
#pragma unroll
                    for (int bj = 0; bj < 2; ++bj) { const f32x4 v0 = acc[ai][bj][m][0], v1 = acc[ai][bj][m][1];
                        const unsigned w0 = (unsigned)__builtin_amdgcn_cvt_pk_fp8_f32(v0[2], v0[3], __builtin_amdgcn_cvt_pk_fp8_f32(v0[0], v0[1], 0, false), true), w1 = (unsigned)__builtin_amdgcn_cvt_pk_fp8_f32(v1[2], v1[3], __builtin_amdgcn_cvt_pk_fp8_f32(v1[0], v1[1], 0, false), true);
                        unsigned char* gp = V8 + ((size_t)(b_ * 4 + 2 * bj + (wc >> 1)) * 128 + tl_) * 4096 + (p_ >> 4) * 1024 + (p_ & 15) + ((wc & 1) * 32 + 8 * fq) * 16;
#pragma unroll
                        for (int j = 0; j < 4; ++j) { gp[j * 16] = (unsigned char)(w0 >> (8 * j)); gp[(4 + j) * 16] = (unsigned char)(w1 >> (8 * j)); } } }
            return;
        }
        if (pn == 2 || pn == 3 || pn >= 7) {
            const bool glu = pn >= 7; const int col0 = (glu ? 1024 + (pn - 7) * HALF : 512 + (pn - 2) * HALF) + wc * 32 + 8 * fq;
#pragma unroll
            for (int ai = 0; ai < 2; ++ai)
#pragma unroll
                for (int m = 0; m < 4; ++m) { bf16_t* rowp = O + (size_t)(row0 + ai * HALF + m * 16) * ldc + col0; f32x4 h0, h1;
                    const f32x4 g0 = acc[ai][0][m][0], g1 = acc[ai][0][m][1], v0 = acc[ai][1][m][0], v1 = acc[ai][1][m][1];
                    if (glu) {
#pragma unroll
                        for (int j = 0; j < 4; ++j) { h0[j] = v0[j] * __builtin_amdgcn_rcpf(1.0f + __builtin_amdgcn_exp2f(g0[j] * -1.4426950408889634f)); h1[j] = v1[j] * __builtin_amdgcn_rcpf(1.0f + __builtin_amdgcn_exp2f(g1[j] * -1.4426950408889634f)); }
                    } else { h0 = g0 * v0; h1 = g1 * v1; }
                    u32x4 w; w.x = cvt_pk_bf16(h0[0], h0[1]); w.y = cvt_pk_bf16(h0[2], h0[3]); w.z = cvt_pk_bf16(h1[0], h1[1]); w.w = cvt_pk_bf16(h1[2], h1[3]);
                    *(u32x4*)rowp = w; }
            return;
        }
        const int cb = pn < 2 ? pn * BM : (pn - 1) * BM;
        const int col0 = cb + wc * 32 + 8 * fq;
        const int mode = (pn == 4) ? 2 : (pn == 5) ? 1 : 0;
#pragma unroll
        for (int ai = 0; ai < 2; ++ai)
#pragma unroll
            for (int m = 0; m < 4; ++m) { const int row = row0 + ai * HALF + m * 16; bf16_t* rowp = O + (size_t)row * ldc + col0;
                f32x4 cs = (f32x4){1.f, 1.f, 1.f, 1.f}, sn = (f32x4){0.f, 0.f, 0.f, 0.f};
                if (mode != 0 && fq == 0) { cs = *(const f32x4*)(cosb + (size_t)row * 4); sn = *(const f32x4*)(sinb + (size_t)row * 4); }
#pragma unroll
                for (int bj = 0; bj < 2; ++bj) { f32x4 v0 = acc[ai][bj][m][0], v1 = acc[ai][bj][m][1];
                    if (mode != 0) { const f32x4 r0 = v0 * cs - v1 * sn, r1 = v1 * cs + v0 * sn; v0 = r0; v1 = r1; if (mode == 2) { v0 = v0 * qscale; v1 = v1 * qscale; } }
                    u32x4 w; w.x = cvt_pk_bf16(v0[0], v0[1]); w.y = cvt_pk_bf16(v0[2], v0[3]); w.z = cvt_pk_bf16(v1[0], v1[1]); w.w = cvt_pk_bf16(v1[2], v1[3]);
                    if (mode == 1) {
                        const int b_ = row >> 13, s_ = row & 8191, tl_ = s_ >> 6, ky_ = s_ & 63;
                        *(u32x4*)(KT + ((((size_t)((b_ * 4 + 2 * bj + (wc >> 1)) * 2 + (wc & 1)) * 128 + tl_) * 64 + ky_) * 64 + ((fq ^ ((ky_ >> 2) & 3)) * 16))) = w;
                    } else *(u32x4*)(rowp + bj * HALF) = w; } }
    }
};
struct EpiRes {
    static constexpr bool PERM = true;
    bf16_t* X; int ldc; float alpha; float ascale;
    __device__ __forceinline__ void operator()(const f32x4 (&acc)[2][2][4][2], const Unit& u, int wr, int wc, int fr, int fq) const {
        const int row0 = u.pm * BM + wr * 64 + fr, col0 = u.pn * BM + wc * 32 + 8 * fq;
#pragma unroll
        for (int ai = 0; ai < 2; ++ai)
#pragma unroll
            for (int m = 0; m < 4; ++m) { bf16_t* rowp = X + (size_t)(row0 + ai * HALF + m * 16) * ldc + col0;
                u32x4 rv[2];
#pragma unroll
                for (int bj = 0; bj < 2; ++bj) rv[bj] = *(const u32x4*)(rowp + bj * HALF);
#pragma unroll
                for (int bj = 0; bj < 2; ++bj) { const f32x4 a0 = acc[ai][bj][m][0], a1 = acc[ai][bj][m][1]; const u32x4 r = rv[bj]; u32x4 w;
                    w.x = cvt_pk_bf16(alpha * __builtin_bit_cast(float, r.x << 16) + a0[0] * ascale, alpha * __builtin_bit_cast(float, r.x & 0xffff0000u) + a0[1] * ascale);
                    w.y = cvt_pk_bf16(alpha * __builtin_bit_cast(float, r.y << 16) + a0[2] * ascale, alpha * __builtin_bit_cast(float, r.y & 0xffff0000u) + a0[3] * ascale);
                    w.z = cvt_pk_bf16(alpha * __builtin_bit_cast(float, r.z << 16) + a1[0] * ascale, alpha * __builtin_bit_cast(float, r.z & 0xffff0000u) + a1[1] * ascale);
                    w.w = cvt_pk_bf16(alpha * __builtin_bit_cast(float, r.w << 16) + a1[2] * ascale, alpha * __builtin_bit_cast(float, r.w & 0xffff0000u) + a1[3] * ascale);
                    *(u32x4*)(rowp + bj * HALF) = w; } }
    }
};
struct EpiResLN {
    static constexpr bool PERM = true;
    bf16_t* X; int ldc; float alpha, ascale; const float* gam; const float* bet; unsigned long long* xbuf; unsigned* cnt; unsigned want; unsigned* tmo; PG8_LAS unsigned char* tab;
    __device__ __forceinline__ void operator()(f32x4 (&acc)[2][2][4][2], const Unit& u, int wr, int wc, int fr, int fq) const {
        const int wid = wr * 4 + wc, lane = fq * 16 + fr;
        PG8_LAS f32x2* P = (PG8_LAS f32x2*)tab;
        PG8_LAS f32x2* S = (PG8_LAS f32x2*)(tab + 8192);
        PG8_LAS unsigned* flag = (PG8_LAS unsigned*)(tab + 8192 + 2048);
        const int row0 = u.pm * BM + wr * 64 + fr, col0 = u.pn * BM + wc * 32 + 8 * fq;
#pragma unroll
        for (int ai = 0; ai < 2; ++ai)
#pragma unroll
            for (int m = 0; m < 4; ++m) { const bf16_t* rowp = X + (size_t)(row0 + ai * HALF + m * 16) * ldc + col0;
                u32x4 rv[2];
#pragma unroll
                for (int bj = 0; bj < 2; ++bj) rv[bj] = *(const u32x4*)(rowp + bj * HALF);
#pragma unroll
                for (int bj = 0; bj < 2; ++bj) { const u32x4 r = rv[bj]; f32x4 a0 = acc[ai][bj][m][0], a1 = acc[ai][bj][m][1];
                    a0[0] = alpha * __builtin_bit_cast(float, r.x << 16) + a0[0] * ascale; a0[1] = alpha * __builtin_bit_cast(float, r.x & 0xffff0000u) + a0[1] * ascale;
                    a0[2] = alpha * __builtin_bit_cast(float, r.y << 16) + a0[2] * ascale; a0[3] = alpha * __builtin_bit_cast(float, r.y & 0xffff0000u) + a0[3] * ascale;
                    a1[0] = alpha * __builtin_bit_cast(float, r.z << 16) + a1[0] * ascale; a1[1] = alpha * __builtin_bit_cast(float, r.z & 0xffff0000u) + a1[1] * ascale;
                    a1[2] = alpha * __builtin_bit_cast(float, r.w << 16) + a1[2] * ascale; a1[3] = alpha * __builtin_bit_cast(float, r.w & 0xffff0000u) + a1[3] * ascale;
                    acc[ai][bj][m][0] = a0; acc[ai][bj][m][1] = a1; } }
#pragma unroll
        for (int ai = 0; ai < 2; ++ai)
#pragma unroll
            for (int m = 0; m < 4; ++m) {
                float s = 0.f;
#pragma unroll
                for (int bj = 0; bj < 2; ++bj)
#pragma unroll
                    for (int n = 0; n < 2; ++n) { const f32x4 x = acc[ai][bj][m][n]; s += (x[0] + x[1]) + (x[2] + x[3]); }
                s += __shfl_xor(s, 16); s += __shfl_xor(s, 32);
                const float mw = s * (1.0f / 64.0f); float q = 0.f;
#pragma unroll
                for (int bj = 0; bj < 2; ++bj)
#pragma unroll
                    for (int n = 0; n < 2; ++n) { const f32x4 d = acc[ai][bj][m][n] - mw; q += (d[0] * d[0] + d[1] * d[1]) + (d[2] * d[2] + d[3] * d[3]); }
                q += __shfl_xor(q, 16); q += __shfl_xor(q, 32);
                if (fq == 0) P[(ai * HALF + wr * 64 + m * 16 + fr) * 4 + wc] = (f32x2){mw, q};
            }
        asm volatile("s_waitcnt lgkmcnt(0)" ::: "memory"); __builtin_amdgcn_s_barrier(); asm volatile("" ::: "memory");
        const int row = wid * 32 + (lane & 31);
        if (lane < 32) {
            const f32x2 a = P[row * 4 + 0], b = P[row * 4 + 1], c = P[row * 4 + 2], d = P[row * 4 + 3];
            const float mt = (a.x + b.x + c.x + d.x) * 0.25f;
            const float da = a.x - mt, db = b.x - mt, dc = c.x - mt, dd = d.x - mt;
            const float m2 = (a.y + b.y) + (c.y + d.y) + 64.0f * ((da * da + db * db) + (dc * dc + dd * dd));
            unsigned long long* slot = xbuf + ((size_t)(u.pm * BM + row) * 4 + u.pn);
            __hip_atomic_store(slot, ((unsigned long long)__builtin_bit_cast(unsigned, m2) << 32) | __builtin_bit_cast(unsigned, mt), __ATOMIC_RELAXED, __HIP_MEMORY_SCOPE_AGENT);
        }
        asm volatile("s_waitcnt vmcnt(0)" ::: "memory");
        if (lane == 0) __hip_atomic_fetch_add(cnt + 16 * u.pm, 1u, __ATOMIC_RELAXED, __HIP_MEMORY_SCOPE_AGENT);
        if (wid == 0) {
            unsigned sp = 0u, dead = 0u;
            while ((unsigned)__builtin_amdgcn_readfirstlane((int)__hip_atomic_load(cnt + 16 * u.pm, __ATOMIC_RELAXED, __HIP_MEMORY_SCOPE_AGENT)) < want) {
                __builtin_amdgcn_s_sleep(2);
                if (++sp > (1u << 20)) { dead = 1u; if (lane == 0) __hip_atomic_store(tmo, 1u, __ATOMIC_RELAXED, __HIP_MEMORY_SCOPE_AGENT); break; } }
            __builtin_amdgcn_fence(__ATOMIC_ACQUIRE, "agent");
            if (lane == 0) flag[0] = dead;
        }
        asm volatile("s_waitcnt vmcnt(0) lgkmcnt(0)" ::: "memory"); __builtin_amdgcn_s_barrier(); asm volatile("" ::: "memory");
        if (lane < 32) {
            const unsigned long long* slot = xbuf + (size_t)(u.pm * BM + row) * 4; float mt[4], m2[4]; float ms = 0.f;
#pragma unroll
            for (int t = 0; t < 4; ++t) { const unsigned long long w = __hip_atomic_load(slot + t, __ATOMIC_RELAXED, __HIP_MEMORY_SCOPE_AGENT); mt[t] = __builtin_bit_cast(float, (unsigned)w); m2[t] = __builtin_bit_cast(float, (unsigned)(w >> 32)); ms += mt[t]; }
            const float mean = ms * 0.25f; float q = 0.f;
#pragma unroll
            for (int t = 0; t < 4; ++t) { const float dm = mt[t] - mean; q += m2[t] + 256.0f * dm * dm; }
            S[row] = (f32x2){mean, 1.0f / sqrtf(q * (1.0f / 1024.0f) + 1e-5f)};
        }
        asm volatile("s_waitcnt lgkmcnt(0)" ::: "memory"); __builtin_amdgcn_s_barrier(); asm volatile("" ::: "memory");
#pragma unroll
        for (int bj = 0; bj < 2; ++bj) { const f32x4 g0 = *(const f32x4*)(gam + col0 + bj * HALF), g1 = *(const f32x4*)(gam + col0 + bj * HALF + 4), b0 = *(const f32x4*)(bet + col0 + bj * HALF), b1 = *(const f32x4*)(bet + col0 + bj * HALF + 4);
#pragma unroll
            for (int ai = 0; ai < 2; ++ai)
#pragma unroll
                for (int m = 0; m < 4; ++m) { const f32x2 sr = S[ai * HALF + wr * 64 + m * 16 + fr]; bf16_t* rowp = X + (size_t)(row0 + ai * HALF + m * 16) * ldc + col0 + bj * HALF;
                    const float rs = sr.y, nc = -sr.x * sr.y; const f32x4 y0 = (acc[ai][bj][m][0] * rs + nc) * g0 + b0, y1 = (acc[ai][bj][m][1] * rs + nc) * g1 + b1;
                    u32x4 w; w.x = cvt_pk_bf16(y0[0], y0[1]); w.y = cvt_pk_bf16(y0[2], y0[3]); w.z = cvt_pk_bf16(y1[0], y1[1]); w.w = cvt_pk_bf16(y1[2], y1[3]);
                    *(u32x4*)rowp = w; } }
    }
};
__device__ __forceinline__ float clamp448(float v) { return __builtin_fminf(__builtin_fmaxf(v, -448.f), 448.f); }
__device__ __forceinline__ unsigned pk_fp8x4(float a, float b, float c, float d) {
    int v = __builtin_amdgcn_cvt_pk_fp8_f32(clamp448(a), clamp448(b), 0, false); v = __builtin_amdgcn_cvt_pk_fp8_f32(clamp448(c), clamp448(d), v, true); return (unsigned)v; }
struct EpiSwiGLU8 {
    static constexpr bool PERM = true;
    unsigned char* O; int ldc; float iscale, hscale;
    __device__ __forceinline__ void operator()(const f32x4 (&acc)[2][2][4][2], const Unit& u, int wr, int wc, int fr, int fq) const {
        const int row0 = u.pm * BM + wr * 64 + fr, col0 = u.pn * HALF + wc * 32 + 8 * fq;
        const float ke = -1.4426950408889634f * iscale, ikh = 1.0f / (iscale * iscale * hscale);
        const f32x2 ke2 = (f32x2){ke, ke}, ikh2 = (f32x2){ikh, ikh};
#pragma unroll
        for (int ai = 0; ai < 2; ++ai)
#pragma unroll
            for (int m = 0; m < 4; ++m) { unsigned char* rowp = O + (size_t)(row0 + ai * HALF + m * 16) * ldc + col0; f32x2 hv[4];
#pragma unroll
                for (int n = 0; n < 2; ++n)
#pragma unroll
                    for (int jj = 0; jj < 2; ++jj) { const f32x4 g4 = acc[ai][0][m][n], u4 = acc[ai][1][m][n];
                        const f32x2 g = jj ? (f32x2){g4[2], g4[3]} : (f32x2){g4[0], g4[1]}, up = jj ? (f32x2){u4[2], u4[3]} : (f32x2){u4[0], u4[1]};
                        const f32x2 t = g * ke2; f32x2 e; e[0] = __builtin_amdgcn_exp2f(t[0]); e[1] = __builtin_amdgcn_exp2f(t[1]);
                        const f32x2 d = e * ikh2 + ikh2; f32x2 r; r[0] = __builtin_amdgcn_rcpf(d[0]); r[1] = __builtin_amdgcn_rcpf(d[1]);
                        hv[n * 2 + jj] = (g * up) * r; }
                u32x2 w; { int v0 = __builtin_amdgcn_cvt_pk_fp8_f32(hv[0][0], hv[0][1], 0, false); v0 = __builtin_amdgcn_cvt_pk_fp8_f32(hv[1][0], hv[1][1], v0, true);
                           int v1 = __builtin_amdgcn_cvt_pk_fp8_f32(hv[2][0], hv[2][1], 0, false); v1 = __builtin_amdgcn_cvt_pk_fp8_f32(hv[3][0], hv[3][1], v1, true); w.x = (unsigned)v0; w.y = (unsigned)v1; }
                *(u32x2*)rowp = w; }
    }
};

__device__ __forceinline__ void glds16s(const void* sbase, unsigned voff, unsigned lds_dst) { unsigned keep;
    asm volatile("s_mov_b32 %0, m0\n\ts_mov_b32 m0, %3\n\ts_nop 0\n\tglobal_load_lds_dwordx4 %1, %2\n\ts_mov_b32 m0, %0" : "=&s"(keep) : "v"(voff), "s"(sbase), "s"(lds_dst) : "memory"); }
template <class Epi, class Sched, bool FP8 = false>
__device__ __forceinline__ void gemm_phase(PG8_LAS unsigned char* lds, const Gemm g, const Sched& S, const Epi& E) {
    constexpr bool GATHER = Sched::GATHER; constexpr bool ASM_DMA = FP8 || PG8_ASM_DMA_ALL;
    int tid = threadIdx.x; asm volatile("" : "+v"(tid));
    const int wid = __builtin_amdgcn_readfirstlane(tid >> 6), lane = tid & 63, wr = wid >> 2, wc = wid & 3, fr = lane & 15, fq = lane >> 4;
    const int K = FP8 ? g.K / 2 : g.K, nt = K / BK;
    unsigned voffA[2], voffB[2]; int RA[2];
#pragma unroll
    for (int i = 0; i < 2; ++i) { int R, C; stage_rc(tid * 16 + i * 8192, R, C); const int Rb = Epi::PERM ? ((R & ~31) + perm32(R & 31)) : R;
        RA[i] = R; voffA[i] = GATHER ? (unsigned)C * 2u : (unsigned)(R * K + C) * 2u; voffB[i] = (unsigned)(Rb * K + C) * 2u; }
    const unsigned K2 = (unsigned)K * 2u;
    const size_t kstep = (size_t)(BK * 2);
    const size_t hstep = (size_t)HALF * K * 2;
    const size_t tstep = 2 * hstep;
    const unsigned ldsw = (unsigned)wid * 1024u; const unsigned ldsb = (unsigned)(uintptr_t)lds;
    const int aoff = lds_byte(wr * 64 + fr, fq * 8), boff = lds_byte(wc * 32 + fr, fq * 8);
#define PG8_SA(b, h) (((b) * 2 + (h)) * HTB)
#define PG8_SB(b, h) ((4 + (b) * 2 + (h)) * HTB)
#define PG8_STAGE(bufoff, gbase, voff) do { _Pragma("unroll") for (int _i = 0; _i < 2; ++_i) { \
        if (ASM_DMA) glds16s((const char*)(gbase), (voff)[_i], (unsigned)__builtin_amdgcn_readfirstlane((int)(ldsb + (unsigned)(bufoff) + ldsw + _i * 8192u))); \
        else __builtin_amdgcn_global_load_lds((const unsigned*)((const char*)(gbase) + (size_t)(voff)[_i]), (PG8_LAS unsigned*)(lds + (bufoff) + ldsw + _i * 8192), 16, 0, 0); } } while (0)
#define PG8_STAGE_A(bufoff, ub, kb, h, go) do { if (GATHER) PG8_STAGE(bufoff, (ub) + (kb), (go)[h]); else PG8_STAGE(bufoff, (ub) + (kb) + (size_t)(h) * hstep, voffA); } while (0)
#define PG8_LD8(p_) __builtin_shufflevector(*(const PG8_LAS v4i_t*)(p_), *(const PG8_LAS v4i_t*)((p_) + 1024), 0, 1, 2, 3, 4, 5, 6, 7)
#define PG8_LDA(dst, b, h) do { _Pragma("unroll") for (int m = 0; m < 4; ++m) { if (FP8) dst##8[m] = PG8_LD8(lds + PG8_SA(b, h) + aoff + m * 2048); else { _Pragma("unroll") for (int k = 0; k < 2; ++k) dst[m][k] = *(const PG8_LAS bf16x8*)(lds + PG8_SA(b, h) + aoff + m * 2048 + k * 1024); } } } while (0)
#define PG8_LDB(dst, b, h) do { _Pragma("unroll") for (int n = 0; n < 2; ++n) { if (FP8) dst##8[n] = PG8_LD8(lds + PG8_SB(b, h) + boff + n * 2048); else { _Pragma("unroll") for (int k = 0; k < 2; ++k) dst[n][k] = *(const PG8_LAS bf16x8*)(lds + PG8_SB(b, h) + boff + n * 2048 + k * 1024); } } } while (0)
#define PG8_MMA_REAL(ai, bj, At, Bt) do { __builtin_amdgcn_s_setprio(1); _Pragma("unroll") for (int m = 0; m < 4; ++m) _Pragma("unroll") for (int n = 0; n < 2; ++n) { \
        if (FP8) asm("v_mfma_scale_f32_16x16x128_f8f6f4 %0, %1, %2, %0, %3, %3 op_sel_hi:[0,0,0]" : "+v"(acc[ai][bj][m][n]) : "v"(Bt##8[n]), "v"(At##8[m]), "v"(sc1));   \
        else { _Pragma("unroll") for (int k = 0; k < 2; ++k) acc[ai][bj][m][n] = __builtin_amdgcn_mfma_f32_16x16x32_bf16(Bt[n][k], At[m][k], acc[ai][bj][m][n], 0, 0, 0); } } \
        __builtin_amdgcn_s_setprio(0); } while (0)
#define PG8_MMA(ai, bj, At, Bt) PG8_MMA_REAL(ai, bj, At, Bt)
#define PG8_WAIT_V(n) asm volatile("s_waitcnt vmcnt(" #n ")" ::: "memory")
#define PG8_WAIT_L(n) asm volatile("s_waitcnt lgkmcnt(" #n ")" ::: "memory")
#define PG8_BAR __builtin_amdgcn_s_barrier()
#define PG8_SCHED __builtin_amdgcn_sched_barrier(0)
#define PG8_OFFS(dst, ui_, u_) do { _Pragma("unroll") for (int _h = 0; _h < 2; ++_h) _Pragma("unroll") for (int _i = 0; _i < 2; ++_i) dst[_h][_i] = GATHER ? S.a_row(ui_, u_, _h * HALF + RA[_i]) * K2 + voffA[_i] : 0u; } while (0)
    Unit cur, nxt; int ui = 0;
    if (!S.next(0, cur)) return;
    f32x4 acc[2][2][4][2];
#pragma unroll
    for (int a = 0; a < 2; ++a)
#pragma unroll
        for (int b = 0; b < 2; ++b)
#pragma unroll
            for (int m = 0; m < 4; ++m)
#pragma unroll
                for (int n = 0; n < 2; ++n) acc[a][b][m][n] = (f32x4){0.f, 0.f, 0.f, 0.f};
    bf16x8 At[4][2], B0[2][2], B1[2][2];
    v8i_t At8[4], B08[2], B18[2];
    const int sc1 = 0x7f7f7f7f;
    unsigned offA[2][2];
    PG8_OFFS(offA, 0, cur);
    const char* cA = (const char*)g.A + (GATHER ? (size_t)0 : (size_t)cur.pm * tstep);
    const char* cB = (const char*)g.Bt + (size_t)cur.pb * tstep;
    PG8_STAGE(PG8_SB(0, 0), cB, voffB); PG8_STAGE(PG8_SB(0, 1), cB + hstep, voffB); PG8_STAGE_A(PG8_SA(0, 0), cA, 0, 0, offA); PG8_STAGE_A(PG8_SA(0, 1), cA, 0, 1, offA);
    if (wr == 1) PG8_BAR;
    PG8_WAIT_V(2); PG8_BAR;
    PG8_STAGE(PG8_SB(1, 0), cB + kstep, voffB); PG8_STAGE_A(PG8_SA(1, 0), cA, kstep, 0, offA); PG8_STAGE(PG8_SB(1, 1), cB + hstep + kstep, voffB);
    PG8_WAIT_V(6); PG8_BAR;
    for (;;) {
        const bool has_next = S.next(ui + 1, nxt);
        const char* nA = (has_next && !GATHER) ? (const char*)g.A + (size_t)nxt.pm * tstep : cA; const char* nB = has_next ? (const char*)g.Bt + (size_t)nxt.pb * tstep : cB;
        for (int t = 0; t < nt; t += 2) {
            const bool last = (t == nt - 2);
            const size_t k1 = (size_t)(t + 1) * kstep;
            const char* a2 = last ? nA : cA; const size_t k2 = last ? (size_t)0 : (size_t)(t + 2) * kstep; const char* b2 = last ? nB : cB + (size_t)(t + 2) * kstep;
            const size_t k3 = k2 + kstep; const char* b3 = b2 + kstep;
            unsigned o2[2][2];
#pragma unroll
            for (int h = 0; h < 2; ++h)
#pragma unroll
                for (int i = 0; i < 2; ++i) o2[h][i] = offA[h][i];
            if (GATHER && last && has_next) { PG8_OFFS(o2, ui + 1, nxt); }
            PG8_LDB(B0, 0, 0); PG8_LDB(B1, 0, 1); PG8_SCHED; PG8_LDA(At, 0, 0); PG8_STAGE_A(PG8_SA(1, 1), cA, k1, 1, offA);
            PG8_WAIT_V(8); PG8_WAIT_L(0); PG8_BAR; PG8_MMA(0, 0, At, B0); PG8_MMA(0, 1, At, B1); PG8_BAR; PG8_SCHED;
            PG8_LDA(At, 0, 1); PG8_STAGE(PG8_SB(0, 0), b2, voffB); PG8_STAGE(PG8_SB(0, 1), b2 + hstep, voffB); PG8_STAGE_A(PG8_SA(0, 0), a2, k2, 0, o2);
            PG8_WAIT_V(8); PG8_WAIT_L(0); PG8_BAR; PG8_MMA(1, 0, At, B0); PG8_MMA(1, 1, At, B1); PG8_BAR; PG8_SCHED;
            PG8_LDB(B0, 1, 0); PG8_LDB(B1, 1, 1); PG8_SCHED; PG8_LDA(At, 1, 0); PG8_STAGE_A(PG8_SA(0, 1), a2, k2, 1, o2);
            PG8_WAIT_V(8); PG8_WAIT_L(0); PG8_BAR; PG8_MMA(0, 0, At, B0); PG8_MMA(0, 1, At, B1); PG8_BAR; PG8_SCHED;
            PG8_LDA(At, 1, 1); PG8_STAGE(PG8_SB(1, 0), b3, voffB); PG8_STAGE(PG8_SB(1, 1), b3 + hstep, voffB); PG8_STAGE_A(PG8_SA(1, 0), a2, k3, 0, o2);
            PG8_WAIT_V(8); PG8_WAIT_L(0); PG8_BAR; PG8_MMA(1, 0, At, B0); PG8_MMA(1, 1, At, B1); PG8_BAR; PG8_SCHED;
            if (GATHER && last) {
#pragma unroll
                for (int h = 0; h < 2; ++h)
#pragma unroll
                    for (int i = 0; i < 2; ++i) offA[h][i] = o2[h][i]; }
        }
        if (FP8) asm volatile("s_nop 15\n\ts_nop 15" ::: "memory");
        if (wr == 0) PG8_BAR;
        E(acc, cur, wr, wc, fr, fq);
        if (!has_next) break;
#pragma unroll
        for (int a = 0; a < 2; ++a)
#pragma unroll
            for (int b = 0; b < 2; ++b)
#pragma unroll
                for (int m = 0; m < 4; ++m)
#pragma unroll
                    for (int n = 0; n < 2; ++n) acc[a][b][m][n] = (f32x4){0.f, 0.f, 0.f, 0.f};
        cur = nxt; cA = nA; cB = nB; ++ui;
        if (wr == 1) PG8_BAR;
    }
    PG8_WAIT_V(0);
    PG8_BAR;
#undef PG8_SA
#undef PG8_SB
#undef PG8_STAGE
#undef PG8_STAGE_A
#undef PG8_LDA
#undef PG8_LDB
#undef PG8_MMA
#undef PG8_MMA_REAL
#undef PG8_LD8
#undef PG8_WAIT_V
#undef PG8_WAIT_L
#undef PG8_BAR
#undef PG8_SCHED
#undef PG8_OFFS
}
}
namespace attn_body {
using bf16=__hip_bfloat16;
using bf16x8=__attribute__((ext_vector_type(8)))short;
using s16x4=__attribute__((ext_vector_type(4)))short;
using f32x16=__attribute__((ext_vector_type(16)))float;
using f32x4=__attribute__((ext_vector_type(4)))float;
using u32x4=__attribute__((ext_vector_type(4)))unsigned;
using u32x2=__attribute__((ext_vector_type(2)))unsigned;
using v4i=__attribute__((ext_vector_type(4)))int;
using v8i=__attribute__((ext_vector_type(8)))int;
constexpr int BATCH=8,NHEAD=4,SEQ=8192,D=64;
constexpr int ZP=1280;
constexpr int YP=1024;
constexpr int QCOL=768,KCOL=1024,VCOL=1280,OCOL=512;
constexpr int NW=8,QBLK=32,QB=QBLK*NW,KVBLK=64,NQB=SEQ/QB;
__device__ __forceinline__ int crow(int r,int hi){return (r&3)+8*(r>>2)+4*hi;}
#define SBAR() __builtin_amdgcn_sched_barrier(0)
__device__ __forceinline__ void cmask(f32x16&p0,f32x16&p1,int jb,int qrel,int hi){
  const float NEG=-INFINITY; int qd=qrel-64*jb-4*hi; asm volatile("":"+v"(qd));
  #pragma unroll
  for(int r=0;r<16;++r){const int kc=(r&3)+8*(r>>2); if(kc>qd)p0[r]=NEG; if(kc+32>qd)p1[r]=NEG;}
}
constexpr int NSLOT=3, SLOTB=8192;
constexpr int LDS_K=0, LDS_V=NSLOT*SLOTB, LDS_WS=2*NSLOT*SLOTB, LDS_OST=LDS_WS+NW*64*4, LDS_ONES=LDS_OST+NW*8192, LDS_BYTES=LDS_ONES+64;
constexpr float C2=8.0f*0.17677669529663687f*1.4426950408889634f;
constexpr float PSH=4.0f;
constexpr float K0=8.0f*(PSH+7.0f)+0.5f;
__device__ __forceinline__ void glds16(const void*sbase,unsigned voff,unsigned lds_dst){unsigned keep;
  asm volatile("s_mov_b32 %0, m0\n\ts_mov_b32 m0, %3\n\ts_nop 0\n\tglobal_load_lds_dwordx4 %1, %2\n\ts_mov_b32 m0, %0":"=&s"(keep):"v"(voff),"s"(sbase),"s"(lds_dst):"memory");}
__device__ __forceinline__ float max3f(float a,float b,float c){float r;asm("v_max3_f32 %0, %1, %2, %3":"=v"(r):"v"(a),"v"(b),"v"(c));return r;}
__device__ __forceinline__ float max2f(float a,float b){float r;asm("v_max_f32_e32 %0, %1, %2":"=v"(r):"v"(a),"v"(b));return r;}
__device__ __forceinline__ float fadd_s(float a,float b){float r;asm("v_add_f32_e32 %0, %1, %2":"=v"(r):"v"(a),"v"(b));return r;}
__device__ __forceinline__ float fsub_s(float a,float b){float r;asm("v_sub_f32_e32 %0, %1, %2":"=v"(r):"v"(a),"v"(b));return r;}
typedef float f32x2_t __attribute__((ext_vector_type(2))); typedef __bf16 bf16x2_t __attribute__((ext_vector_type(2)));
__device__ __forceinline__ unsigned cvtpk_s(float lo,float hi){f32x2_t v={lo,hi};bf16x2_t b=__builtin_convertvector(v,bf16x2_t);return __builtin_bit_cast(unsigned,b);}
#define WAIT_BAR(N) asm volatile("s_waitcnt vmcnt(" #N ") lgkmcnt(0)\n\ts_barrier":::"memory")
#define WAIT_BAR_KV(NK,NV) do{ if(isK){WAIT_BAR(NK);} else {WAIT_BAR(NV);} }while(0)
typedef __attribute__((address_space(3))) const char* lds_cptr;
typedef short v4i16_t __attribute__((ext_vector_type(4)));
__device__ __forceinline__ void kload2(bf16x8*kf,lds_cptr kp,int ka,int kb,int j){ const int o=j?kb:ka; kf[2*j]=*(const __attribute__((address_space(3))) bf16x8*)(kp+o); kf[2*j+1]=*(const __attribute__((address_space(3))) bf16x8*)(kp+o+2048); }
__device__ __forceinline__ float rowmax(const f32x16&p0,const f32x16&p1){
  float a=max3f(p0[0],p0[1],p1[0]),b=max3f(p0[2],p0[3],p1[1]);a=max3f(a,p1[2],p1[3]);
  #pragma unroll
  for(int r=4;r<16;r+=4){a=max3f(a,p0[r],p0[r+1]);b=max3f(b,p0[r+2],p0[r+3]);a=max3f(a,p1[r],p1[r+1]);b=max3f(b,p1[r+2],p1[r+3]);}
  const float m=max2f(a,b);
  auto rr=__builtin_amdgcn_permlane32_swap(__float_as_uint(m),__float_as_uint(m),false,false);
  return max2f(__uint_as_float(rr[0]),__uint_as_float(rr[1]));
}

struct AttnParams { const bf16* Z; bf16* Y; float lam; float osc; const float* subg; const unsigned char* V8; const unsigned char* KT; };
template<int THRL> __device__ __forceinline__ void attn_unit(int b,int h,int qb,const AttnParams&P,char*shm){
  int tid=threadIdx.x; asm volatile("":"+v"(tid));
  const int lane=tid&63,r32=lane&31,hi=lane>>5; const int wid=__builtin_amdgcn_readfirstlane(tid>>6);
  const long rowbase=(long)b*SEQ; const int q0=qb*QB;
  const bf16*Z=P.Z;
  const unsigned lds0=(unsigned)(uintptr_t)shm;
  float*wsf=(float*)(shm+LDS_WS)+wid*64;
  if(tid<8)((unsigned*)(shm+LDS_ONES))[tid]=0x38383838u;
  const unsigned char*KTh=P.KT+(size_t)((b*NHEAD+h)*2)*(128*4096);
  const bool isK=wid<4;
  const unsigned doff=(unsigned)((wid&3)*1024+lane*16);
  const unsigned char*V8h=P.V8+(size_t)(b*NHEAD+h)*(128*4096);
  const unsigned ddst=lds0+(isK?LDS_K:LDS_V)+(wid&3)*1024;
  const long dstep=4096L;
  #define DMA_K(t,slot) do{ if(isK){ glds16(pn,doff,(unsigned)__builtin_amdgcn_readfirstlane(ddst+(slot))); pn+=dstep; } }while(0)
  #define DMA_V(t,slot) do{ if(!isK){ glds16(pn,doff,(unsigned)__builtin_amdgcn_readfirstlane(ddst+(slot))); pn+=dstep; } }while(0)
  const lds_cptr shm3=(lds_cptr)shm; const lds_cptr vp0=shm3+LDS_V+hi*2048+r32*16;
  const int NT=(q0+QB)/KVBLK;
  const int qrel=wid*QBLK+r32;
  for(int mp=0;mp<2;++mp){
  const bf16*Qw=Z+(rowbase+q0+wid*QBLK)*ZP+QCOL+h*D+mp*32;
  const lds_cptr kp0=shm3+LDS_K; const int ka=r32*64+((hi^((r32>>2)&3))*16), kb=ka^32;
  bf16x8 kf[4];
  const char*pn=isK?(const char*)(KTh+(size_t)mp*(128*4096)):(const char*)V8h;
  DMA_K(0,0);DMA_V(0,0);DMA_K(1,SLOTB);
  bf16x8 qr[2];
  #pragma unroll
  for(int d0=0;d0<2;++d0)qr[d0]=*reinterpret_cast<const bf16x8*>(&Qw[(long)r32*ZP+d0*16+hi*8]);
  float mhat=0.f;f32x16 o[2];o[0]=f32x16{};o[1]=f32x16{};f32x4 osum=f32x4{};f32x16 negm; { float z0_; asm volatile("v_mov_b32 %0, %1":"=v"(z0_):"s"(K0)); _Pragma("unroll") for(int r=0;r<16;++r)negm[r]=z0_; } asm volatile("":"+v"(negm));
  int sc1=0x7f7f7f7f;asm volatile("":"+v"(sc1));
  v8i onesB; { int ob_=(((lane>>4)&1)==((lane>>3)&1))?0x38383838:0; asm volatile("":"+v"(ob_)); _Pragma("unroll") for(int r=0;r<8;++r)onesB[r]=ob_; } asm volatile("":"+v"(onesB));
  #define CMASK(P0,P1,t) do{int jb_=(t)-(NT-4); if(jb_>=0)cmask(P0,P1,jb_,qrel,hi);}while(0)
  bool resc=false;
  #define START(P0,P1) do{ const float rm=rowmax(P0,P1); resc=false; \
    { const float dl=rm-K0; mhat=fadd_s(mhat,dl); \
      _Pragma("unroll") for(int r=0;r<16;++r){P0[r]=fsub_s(P0[r],dl);P1[r]=fsub_s(P1[r],dl);} \
      _Pragma("unroll") for(int r=0;r<16;++r)negm[r]=K0-mhat; asm volatile("":"+v"(negm)); } }while(0)
  #define RESC() do{ if(resc){ asm volatile("s_waitcnt lgkmcnt(0)\n\ts_nop 15\n\ts_nop 15\n\ts_nop 15\n\ts_nop 15\n\ts_nop 15":"+v"(o[0]),"+v"(o[1]),"+v"(osum)::"memory");   \
      _Pragma("unroll") for(int r=0;r<16;++r){const float f_=wsf[crow(r,hi)];o[0][r]*=f_;o[1][r]*=f_;} \
      _Pragma("unroll") for(int i=0;i<4;++i)osum[i]*=wsf[4*(lane>>4)+16*((lane>>3)&1)+i]; } }while(0)
  f32x16 pA0,pA1; v8i pwA,pwB;
  int sl_prev=0,sl_cur=0,sl_next=SLOTB;
  #define ROT() do{sl_prev=sl_cur;sl_cur=sl_next;sl_next=(sl_next==(NSLOT-1)*SLOTB)?0:sl_next+SLOTB;}while(0)
  DMA_K(2,2*SLOTB);
  WAIT_BAR(2);
  { kload2(kf,kp0,ka,kb,0); kload2(kf,kp0,ka,kb,1);
    pA0=__builtin_amdgcn_mfma_f32_32x32x16_bf16(kf[0],qr[0],negm,0,0,0); pA1=__builtin_amdgcn_mfma_f32_32x32x16_bf16(kf[1],qr[0],negm,0,0,0);
    pA0=__builtin_amdgcn_mfma_f32_32x32x16_bf16(kf[2],qr[1],pA0,0,0,0);  pA1=__builtin_amdgcn_mfma_f32_32x32x16_bf16(kf[3],qr[1],pA1,0,0,0); }
  asm volatile("s_nop 15\n\ts_nop 7":"+v"(pA0),"+v"(pA1));CMASK(pA0,pA1,0);
  START(pA0,pA1);
  #define CV4(P,B) __builtin_amdgcn_cvt_pk_u8_f32(P[(B)+3],3,__builtin_amdgcn_cvt_pk_u8_f32(P[(B)+2],2,__builtin_amdgcn_cvt_pk_u8_f32(P[(B)+1],1,__builtin_amdgcn_cvt_pk_u8_f32(P[B],0,0u))))
  #define PACK(PW,P0,P1) do{ PW[0]=(int)CV4(P0,0);PW[1]=(int)CV4(P0,4);PW[2]=(int)CV4(P0,8);PW[3]=(int)CV4(P0,12);PW[4]=(int)CV4(P1,0);PW[5]=(int)CV4(P1,4);PW[6]=(int)CV4(P1,8);PW[7]=(int)CV4(P1,12); }while(0)
  PACK(pwA,pA0,pA1);
  WAIT_BAR(0);
  DMA_K(3,0);DMA_V(1,SLOTB);
  ROT();
  kload2(kf,kp0+sl_cur,ka,kb,0); kload2(kf,kp0+sl_cur,ka,kb,1);
  WAIT_BAR(1);
  v8i vf8[2];
  #define PIN(x) asm volatile("":"+v"(x))
  #define MX3(a,b,c) __builtin_fmaxf(__builtin_fmaxf((a),(b)),(c))
  #define MF8(ACC,B8,PW) asm volatile("v_mfma_scale_f32_32x32x64_f8f6f4 %0, %1, %2, %0, %3, %3 op_sel_hi:[0,0,0]":"+v"(ACC):"v"(PW),"v"(B8),"v"(sc1))
  #define MFS(ACC,PW) asm volatile("v_mfma_scale_f32_16x16x128_f8f6f4 %0, %1, %2, %0, %3, %3 op_sel_hi:[0,0,0]":"+v"(ACC):"v"(PW),"v"(onesB),"v"(sc1))
  #define ONES8() do{ const v4i a_=*(const __attribute__((address_space(3))) v4i*)(shm3+LDS_ONES), b_=*(const __attribute__((address_space(3))) v4i*)(shm3+LDS_ONES+16); vf8[0]=__builtin_shufflevector(a_,b_,0,1,2,3,4,5,6,7); }while(0)
  #define VRD8(d0) do{ const v4i a_=*(const __attribute__((address_space(3))) v4i*)(vp_+(d0)*512), b_=*(const __attribute__((address_space(3))) v4i*)(vp_+(d0)*512+1024); vf8[d0]=__builtin_shufflevector(a_,b_,0,1,2,3,4,5,6,7); }while(0)
  #define KRD(G,j) do{ if(G){ kload2(kf,kp0+sl_next,ka,kb,j); SBAR(); } }while(0)
  #define STEP(C0,C1,PWP,PWN,t,GK,GV,GL) do{ SBAR(); \
    const lds_cptr vp_=vp0+sl_prev; \
    VRD8(0); SBAR(); \
    C0=__builtin_amdgcn_mfma_f32_32x32x16_bf16(kf[0],qr[0],negm,0,0,0); \
    C1=__builtin_amdgcn_mfma_f32_32x32x16_bf16(kf[1],qr[0],negm,0,0,0); \
    VRD8(1); SBAR(); \
    C0=__builtin_amdgcn_mfma_f32_32x32x16_bf16(kf[2],qr[1],C0,0,0,0); \
    C1=__builtin_amdgcn_mfma_f32_32x32x16_bf16(kf[3],qr[1],C1,0,0,0); \
    if(GK){DMA_K((t)+3,sl_cur);} if(GV){DMA_V((t)+1,sl_next);} \
    CMASK(C0,C1,t); \
    { float a=MX3(C0[0],C0[1],C1[0]),b=MX3(C0[2],C0[3],C1[1]); a=MX3(a,C1[2],C1[3]); \
      _Pragma("unroll") for(int r=4;r<16;r+=4){a=MX3(a,C0[r],C0[r+1]);b=MX3(b,C0[r+2],C0[r+3]);a=MX3(a,C1[r],C1[r+1]);b=MX3(b,C1[r+2],C1[r+3]);} \
      float rm=__builtin_fmaxf(a,b); { auto rr=__builtin_amdgcn_permlane32_swap(__float_as_uint(rm),__float_as_uint(rm),false,false); rm=__builtin_fmaxf(__uint_as_float(rr[0]),__uint_as_float(rr[1])); } \
      resc=false; \
      if(__builtin_expect(__any(rm>8.0f*(float)THRL+K0),0)){ const float dl=__builtin_fmaxf(rm-K0,0.f); mhat+=dl; \
        _Pragma("unroll") for(int r=0;r<16;++r){C0[r]-=dl;C1[r]-=dl;} \
        _Pragma("unroll") for(int r=0;r<16;++r)negm[r]=K0-mhat; asm volatile("":"+v"(negm)); \
        const float f=__builtin_amdgcn_exp2f(-0.125f*dl); if(hi==0)wsf[r32]=f; resc=true; } } \
    SBAR(); \
    MF8(o[0],vf8[0],PWP); PWN[0]=(int)CV4(C0,0);PWN[1]=(int)CV4(C0,4);PWN[2]=(int)CV4(C0,8);PWN[3]=(int)CV4(C0,12); PIN(PWN); SBAR(); \
    KRD(GL,0); \
    MF8(o[1],vf8[1],PWP); PWN[4]=(int)CV4(C1,0);PWN[5]=(int)CV4(C1,4);PWN[6]=(int)CV4(C1,8);PWN[7]=(int)CV4(C1,12); PIN(PWN); SBAR(); \
    KRD(GL,1); \
    MFS(osum,PWP); SBAR(); \
    }while(0)
  int t=1;
  #undef CMASK
  #define CMASK(P0,P1,t) do{}while(0)
  for(;t+5<NT;t+=2){
    STEP(pA0,pA1,pwA,pwB,t,true,true,true);     WAIT_BAR(1); RESC(); ROT();
    STEP(pA0,pA1,pwB,pwA,t+1,true,true,true);   WAIT_BAR(1); RESC(); ROT();
  }
  #undef CMASK
  #define CMASK(P0,P1,t) do{int jb_=(t)-(NT-4); if(jb_>=0)cmask(P0,P1,jb_,qrel,hi);}while(0)
  #define ENDW(tt) do{ if((tt)+3<NT){WAIT_BAR(1);} else if((tt)+2<NT){WAIT_BAR_KV(0,1);} else {WAIT_BAR(0);} }while(0)
  for(;t+1<NT;t+=2){
    STEP(pA0,pA1,pwA,pwB,t,(t+3<NT),(t+1<NT),(t+1<NT));       ENDW(t);   RESC(); ROT();
    STEP(pA0,pA1,pwB,pwA,t+1,(t+4<NT),(t+2<NT),(t+2<NT));     ENDW(t+1); RESC(); ROT();
  }
  STEP(pA0,pA1,pwA,pwB,NT-1,false,false,false); RESC();
  { const lds_cptr vp_=vp0+sl_cur; VRD8(0); VRD8(1); SBAR();
    asm volatile("s_nop 7":::"memory");
    MF8(o[0],vf8[0],pwB); MF8(o[1],vf8[1],pwB); asm volatile("s_nop 15":::"memory"); MFS(osum,pwB);
    asm volatile("s_nop 15\n\ts_nop 15\n\ts_nop 15\n\ts_nop 15\n\ts_nop 15":"+v"(o[0]),"+v"(o[1]),"+v"(osum)); }
  #undef CV4
  #undef PACK
  #undef PIN
  #undef MX3
  #undef MF8
  #undef VRD8
  #undef ONES8
  #undef MFS
  #undef KRD
  #undef STEP
  #undef ENDW
  #undef CMASK
  #undef START
  #undef RESC
  #undef ROT
  { int le=lane; asm volatile("":"+v"(le)); const int r32e=le&31,hie=le>>5;
    float*oste=(float*)(shm+LDS_OST)+wid*2048;
    float rli[16];
    #pragma unroll
    for(int r=0;r<16;++r)rli[r]=0.f;
    { float*wse=(float*)(shm+LDS_WS)+wid*64;
      if((le&7)==0){ const int q_=4*(le>>4)+16*((le>>3)&1); _Pragma("unroll") for(int i=0;i<4;++i)wse[q_+i]=osum[i]; }
      asm volatile("s_waitcnt lgkmcnt(0)":::"memory");
      _Pragma("unroll") for(int r=0;r<16;++r)rli[r]=__builtin_amdgcn_rcpf(wse[(r&3)+8*(r>>2)+4*hie]);
      asm volatile("s_waitcnt lgkmcnt(0)":::"memory"); }
    if(mp==0){
      float*pk=oste+le;
      #pragma unroll
      for(int d0=0;d0<2;++d0)
        #pragma unroll
        for(int r=0;r<16;++r)pk[(d0*16+r)*64]=o[d0][r]*rli[r];
    } else {
      const float lam=P.lam; const float*pk=oste+le;
      #pragma unroll
      for(int d0=0;d0<2;++d0)
        #pragma unroll
        for(int r=0;r<16;++r)o[d0][r]=pk[(d0*16+r)*64]-lam*(o[d0][r]*rli[r]);
      asm volatile("s_waitcnt lgkmcnt(0)":::"memory");
      { float*st=oste+(4*hie)*64+r32e;
        #pragma unroll
        for(int r=0;r<16;++r){
          #pragma unroll
          for(int d0=0;d0<2;++d0)st[((r&3)+8*(r>>2))*64+d0*32]=o[d0][r];} }
      asm volatile("s_waitcnt lgkmcnt(0)":::"memory");
      const int ch=le&15, rw=le>>4;
      bf16*Ow=P.Y+(rowbase+q0+wid*QBLK+rw)*YP+OCOL+h*D+ch*4;
      const float*rd=oste+rw*64+ch*4;
      const f32x4 gv=*(const f32x4*)(P.subg+ch*4); const float osc=P.osc;
      #pragma unroll
      for(int i=0;i<8;++i){ const f32x4 v=*(const f32x4*)(rd+i*256);
        float ss=(v[0]*v[0]+v[1]*v[1])+(v[2]*v[2]+v[3]*v[3]);
        ss+=__shfl_xor(ss,1); ss+=__shfl_xor(ss,2); ss+=__shfl_xor(ss,4); ss+=__shfl_xor(ss,8);
        const float rs=(1.0f/sqrtf(ss*(1.0f/64.0f)+1e-5f))*osc;
        u32x2 w; w.x=cvtpk_s(v[0]*rs*gv[0],v[1]*rs*gv[1]); w.y=cvtpk_s(v[2]*rs*gv[2],v[3]*rs*gv[3]);
        *(u32x2*)(Ow+(long)i*4*YP)=w; }
    }
  }
  asm volatile("s_waitcnt lgkmcnt(0)\n\ts_barrier":::"memory");
  }
  #undef DMA_K
  #undef DMA_V
}
constexpr int ATTN_LDS_BYTES=LDS_BYTES;
template<int THRL=8> __device__ __forceinline__ void attn_phase(char*lds,const AttnParams&P,int vcu,int G){
  for(int w=vcu;w<256;w+=G){
    const int s=w&7,bh=w>>3;
    for(int i=0;i<4;++i){ const int qb=(i==0)?s:(i==1)?15-s:(i==2)?16+s:31-s; attn_unit<THRL>(bh/NHEAD,bh%NHEAD,qb,P,lds); }
  }
}
#undef SBAR
#undef WAIT_BAR
}
constexpr int NWAVES = 8;
constexpr int BATCH = 8, SEQ = 8192, D = 1024, M = BATCH * SEQ, DEPTH = 4;
constexpr int NZ = 2304, FF = 2816, FE = 3584, NE = 8;
constexpr int ZW = 1280;
constexpr int NGU = 2 * FF, NGUE = 2 * FE;
constexpr float LN_EPS = 1e-5f;
constexpr float DN_ALPHA = 1.6817928305074292f;
constexpr int MOE_CH = 256;
constexpr int MOE_NCH = 2;
constexpr int MOE_SEAMS = 4;
constexpr int MOE_MAXU = 520;
constexpr size_t MiB = 1u << 20;
constexpr size_t WS_CTL = 0, CTL_ZERO_BYTES = 128 * 1024;
constexpr size_t WS_WIN = 1 * MiB;
constexpr size_t WS_WO = 19 * MiB;
constexpr size_t WS_WGU = 27 * MiB;
constexpr size_t WS_WD = 49 * MiB;
constexpr size_t WS_MGU = 60 * MiB;
constexpr size_t WS_MD = 172 * MiB;
constexpr size_t WS_V8T = 292 * MiB;
constexpr size_t WS_XLN = 310 * MiB;
constexpr size_t WS_WGU8 = 314 * MiB;
constexpr size_t WS_KT = 348 * MiB;
constexpr size_t WS_V8R = 330 * MiB;
constexpr size_t WS_XB8 = 228 * MiB;
constexpr float W1_SCALE = 32.f, WD_SCALE = 128.f, H_SCALE = 4.f;
constexpr size_t WS_ROPE = 396 * MiB;
constexpr size_t WS_LIST = 398 * MiB;
constexpr size_t WS_TOK = 400 * MiB;
constexpr size_t WS_XB = 401 * MiB;
constexpr size_t WS_R = 529 * MiB;
constexpr size_t R_Z = 0, R_Y = 288 * MiB;
constexpr size_t R_H = 0;
constexpr size_t R_HM = 0, R_F = 231 * MiB;
constexpr size_t WS_END = WS_R + 491 * MiB;
constexpr size_t WS_NEED = WS_END;
constexpr int CW_TMO = 0, CW_CODE = 1;
constexpr int CW_BAR = 4096;
constexpr int CW_LNC = 20480;
constexpr int CW_CNT = 16384;
constexpr int RING_OFF = 0, RING_BYTES = 131072;
constexpr int ROWTAB_OFF = RING_BYTES;
constexpr int LNTAB_OFF = ROWTAB_OFF;
constexpr int RUEXP_OFF = ROWTAB_OFF + 29 * 512;
constexpr int LDSCTL_OFF = RUEXP_OFF + 1024, MISC_OFF = LDSCTL_OFF;
constexpr int LDS_BYTES = 147456;
static_assert(MISC_OFF + 256 <= LDS_BYTES, "LDS map");

#define GAS __attribute__((address_space(1)))
#define LAS __attribute__((address_space(3)))
typedef unsigned short bf16;
typedef unsigned v4u __attribute__((ext_vector_type(4)));
typedef unsigned v2u __attribute__((ext_vector_type(2)));
typedef float f32x4 __attribute__((ext_vector_type(4)));
typedef float f32x2 __attribute__((ext_vector_type(2)));
typedef GAS unsigned gu32;
#define RLX_AGENT __ATOMIC_RELAXED, __HIP_MEMORY_SCOPE_AGENT
#define LDS_WAIT() asm volatile("s_waitcnt lgkmcnt(0)" ::: "memory")
#define VM_WAIT() asm volatile("s_waitcnt vmcnt(0)" ::: "memory")
__device__ __forceinline__ unsigned f2bf(float f) { unsigned u = __builtin_bit_cast(unsigned, f); return (u + 0x7fffu + ((u >> 16) & 1u)) >> 16; }
__device__ __forceinline__ unsigned pk2(float lo, float hi) { unsigned r; asm("v_cvt_pk_bf16_f32 %0, %1, %2" : "=v"(r) : "v"(lo), "v"(hi)); return r; }
__device__ __forceinline__ float bf2f(unsigned short b) { return __builtin_bit_cast(float, (unsigned)b << 16); }
__device__ __forceinline__ float bflo(unsigned w) { return __builtin_bit_cast(float, w << 16); }
__device__ __forceinline__ float bfhi(unsigned w) { return __builtin_bit_cast(float, w & 0xffff0000u); }

#define XB_TMO      128
#define XB_XCNT(j)  (256  + 64 * (j))
#define XB_XSUB(j)  (1280 + 64 * (j))
#define XB_XGEN(j)  (2304 + 64 * (j))
#define XB_TOP      3328
#define XB_TOPGEN   3392
#define XCD_BAR_WORDS 3456
#define XB_SPIN_CAP (1u << 18)
__device__ __forceinline__ unsigned xb_ld(unsigned* p)              { return __hip_atomic_load(p, __ATOMIC_RELAXED, __HIP_MEMORY_SCOPE_AGENT); }
__device__ __forceinline__ unsigned xb_add(unsigned* p, unsigned v) { return __hip_atomic_fetch_add(p, v, __ATOMIC_RELAXED, __HIP_MEMORY_SCOPE_AGENT); }
__device__ __forceinline__ unsigned xb_xcc_id() { return (unsigned)__builtin_amdgcn_s_getreg((3 << 11) | 20) & 0xFu; }
#define XB_SPIN(cond, bar) do { unsigned _sp = 0; while (cond) { __builtin_amdgcn_s_sleep(1); \
    if ((++_sp & 255u) == 0u) { if (xb_ld(&(bar)[XB_TMO])) break; if (_sp > XB_SPIN_CAP) { atomicAdd(&(bar)[XB_TMO], 1u); break; } } } } while (0)
struct XcdBarrier { unsigned* bar; unsigned x; volatile LAS unsigned* st; };
__device__ __forceinline__ XcdBarrier xcd_barrier_post(unsigned* bar, volatile LAS unsigned* st) {
    XcdBarrier b; b.bar = bar; b.x = xb_xcc_id(); b.st = st;
    if (threadIdx.x == 0) (void)xb_add(&bar[XB_XCNT(b.x)], 1u);
    return b;
}
__device__ __forceinline__ void xcd_barrier_complete(unsigned* bar, unsigned x, unsigned& nloc, unsigned& nx) {
    const unsigned G = gridDim.x * gridDim.y * gridDim.z;
    unsigned sum, cnt, mine, sp = 0u;
    for (;;) {
        sum = 0u; cnt = 0u; mine = 0u;
#pragma unroll
        for (unsigned j = 0; j < 16; ++j) { const unsigned c = xb_ld(&bar[XB_XCNT(j)]); sum += c; cnt += (c > 0u) ? 1u : 0u; mine = (j == x) ? c : mine; }
        if (sum == G) break;
        __builtin_amdgcn_s_sleep(1);
        if ((++sp & 255u) == 0u) { if (xb_ld(&bar[XB_TMO])) break; if (sp > XB_SPIN_CAP) { atomicAdd(&bar[XB_TMO], 1u); break; } }
    }
    nloc = mine > 0u ? mine : 1u; nx = cnt > 0u ? cnt : 1u;
}
__device__ __forceinline__ void xcd_barrier(const XcdBarrier& b) {
    asm volatile("s_waitcnt vmcnt(0)" ::: "memory");
    __syncthreads();
    if (threadIdx.x == 0) {
        unsigned* bar = b.bar;
        __builtin_amdgcn_s_waitcnt(0);
        unsigned nloc = b.st[0], nx = b.st[1];
        if (nloc == 0u) { xcd_barrier_complete(bar, b.x, nloc, nx); b.st[0] = nloc; b.st[1] = nx; }
        const unsigned old = xb_add(&bar[XB_XSUB(b.x)], 1u);
        const unsigned gen = old / nloc;
        if (old + 1u == (gen + 1u) * nloc) {
            __builtin_amdgcn_fence(__ATOMIC_RELEASE, "agent");
            asm volatile("s_waitcnt vmcnt(0)" ::: "memory");
            const unsigned og = xb_add(&bar[XB_TOP], 1u);
            const unsigned tg = og / nx;
            if (og + 1u == (tg + 1u) * nx) xb_add(&bar[XB_TOPGEN], 1u);
            else XB_SPIN(xb_ld(&bar[XB_TOPGEN]) == tg, bar);
            __builtin_amdgcn_fence(__ATOMIC_ACQUIRE, "agent");
            xb_add(&bar[XB_XGEN(b.x)], 1u);
            asm volatile("s_waitcnt vmcnt(0)" ::: "memory");
        } else {
            XB_SPIN(xb_ld(&bar[XB_XGEN(b.x)]) == gen, bar);
            __builtin_amdgcn_fence(__ATOMIC_ACQUIRE, "agent");
            asm volatile("s_waitcnt vmcnt(0)" ::: "memory");
        }
    }
    __syncthreads();
}

struct Args {
    const float* x; const int* pos; const float* w_in; const float* w_o; const float* pool_w; const float* pool_scale; const float* sconv_w; const float* dlam; const float* subg;
    const float* conf_dw; const float* conf_g; const float* conf_b; const float* ln1_g; const float* ln1_b; const float* ln2_g; const float* ln2_b;
    const float* ffn_wg; const float* ffn_wu; const float* ffn_wd; const float* router; const float* moe_wg; const float* moe_wu; const float* moe_wd;
    float* out; unsigned char* ws; int ph_lo, ph_hi;
};
struct Frame { LAS unsigned char* lds; gu32* ctl; int tid, lane, wave, vcu, G; };

__device__ __forceinline__ float wave_sum(float v) {
#pragma unroll
    for (int o = 1; o < 64; o <<= 1) v += __shfl_xor(v, o);
    return v;
}

__device__ __forceinline__ void p0_transpose_item(const float* W, int K, int N, bf16* WT, int kb, int nb, int drow0, const float* poolw, const float* pools, LAS float* scr, int lane) {
    const int k0 = 64 * kb, n0 = 32 * nb;
    if (poolw) {
        const int n = n0 + (lane & 31), g = n >> 6, e = n & 63; const float sc = pools[n];
        for (int i = 0; i < 32; ++i) { const int kk = 2 * i + (lane >> 5); const float* wr = W + (size_t)(k0 + kk) * N + 64 * g; float a = 0.f;
            for (int c = 0; c < 64; ++c) a += wr[c] * poolw[(g * 64 + c) * 64 + e];
            scr[kk * 33 + (lane & 31)] = a * sc; }
    } else {
        const float* src = W + (size_t)(k0 + (lane >> 5)) * N + n0 + (lane & 31); float t[32];
#pragma unroll
        for (int i = 0; i < 32; ++i) t[i] = src[(size_t)(2 * i) * N];
#pragma unroll
        for (int i = 0; i < 32; ++i) scr[(2 * i + (lane >> 5)) * 33 + (lane & 31)] = t[i];
    }
    LDS_WAIT(); asm volatile("" ::: "memory");
    const int c = lane & 7;
#pragma unroll
    for (int j = 0; j < 4; ++j) { const int n = (lane >> 3) + 8 * j; const LAS float* s = scr + (8 * c) * 33 + n;
        v4u o; o.x = pk2(s[0 * 33], s[1 * 33]); o.y = pk2(s[2 * 33], s[3 * 33]); o.z = pk2(s[4 * 33], s[5 * 33]); o.w = pk2(s[6 * 33], s[7 * 33]);
        *(GAS v4u*)(WT + (size_t)(drow0 + n) * K + k0 + 8 * c) = o; }
    LDS_WAIT(); asm volatile("" ::: "memory");
}
__device__ __forceinline__ void p0_transpose_item8(const float* W, int K, int N, unsigned char* WT, int kb, int nb, int drow0, float scale, LAS float* scr, int lane) {
    const int k0 = 128 * kb, n0 = 32 * nb;
    const float* src = W + (size_t)(k0 + (lane >> 5)) * N + n0 + (lane & 31);
    float t[64];
#pragma unroll
    for (int i = 0; i < 64; ++i) t[i] = src[(size_t)(2 * i) * N];
#pragma unroll
    for (int i = 0; i < 64; ++i) scr[(2 * i + (lane >> 5)) * 33 + (lane & 31)] = t[i];
    LDS_WAIT(); asm volatile("" ::: "memory");
    const int c = lane & 7;
#pragma unroll
    for (int j = 0; j < 4; ++j) { const int n = (lane >> 3) + 8 * j; const LAS float* s = scr + (16 * c) * 33 + n; v4u o;
        o.x = pg8::pk_fp8x4(s[0 * 33] * scale, s[1 * 33] * scale, s[2 * 33] * scale, s[3 * 33] * scale); o.y = pg8::pk_fp8x4(s[4 * 33] * scale, s[5 * 33] * scale, s[6 * 33] * scale, s[7 * 33] * scale);
        o.z = pg8::pk_fp8x4(s[8 * 33] * scale, s[9 * 33] * scale, s[10 * 33] * scale, s[11 * 33] * scale); o.w = pg8::pk_fp8x4(s[12 * 33] * scale, s[13 * 33] * scale, s[14 * 33] * scale, s[15 * 33] * scale);
        *(GAS v4u*)(WT + (size_t)(drow0 + n) * K + k0 + 16 * c) = o; }
    LDS_WAIT(); asm volatile("" ::: "memory");
}
__device__ __forceinline__ int win_row(int n) {
    if (n >= 512 && n < 1024) { const int hv = n >= 768, i = n - (hv ? 768 : 512); return 512 + (i >> 7) * 256 + hv * 128 + (i & 127); }
    if (n >= 1792) { const int gt = n >= 2048, i = n - (gt ? 2048 : 1792); return 1792 + (i >> 7) * 256 + (gt ? 0 : 128) + (i & 127); }
    return n;
}
__device__ __forceinline__ void p0_prologue(const Args& a, Frame& F) {
    LAS float* scr = (LAS float*)(F.lds + RING_OFF + F.wave * 16896);
    const int gw = F.vcu * NWAVES + F.wave, NGW = F.G * NWAVES;
    unsigned char* ws = a.ws;
    constexpr int IA = 16 * 72, IB = 16 * 32, IC = 16 * 88, ID = 22 * 32, IE = 8 * 112, IF = 28 * 32, IG = 8 * 88;
    constexpr int NA = 4 * IA, NB = 4 * IB, NC = 4 * IC, ND = 2 * ID, NEI = 32 * IE, NF = 16 * IF, NG = 2 * IG;
    constexpr int NITEMS = NA + NB + NC + ND + NEI + NF + NG;
    for (int it = gw; it < NITEMS; it += NGW) {
        int r = it;
        if (r < NA) { const int l = r / IA, s = r % IA, kb = s / 72, nb = s % 72;
            p0_transpose_item(a.w_in + (size_t)l * D * NZ, D, NZ, (bf16*)(ws + WS_WIN) + (size_t)l * NZ * D, kb, nb, win_row(32 * nb), nb < 8 ? a.pool_w + (size_t)l * 4 * 64 * 64 : nullptr, a.pool_scale + l * 256, scr, F.lane); continue; } r -= NA;
        if (r < NB) { const int l = r / IB, s = r % IB, kb = s / 32, nb = s % 32;
            p0_transpose_item(a.w_o + (size_t)l * D * D, D, D, (bf16*)(ws + WS_WO) + (size_t)l * D * D, kb, nb, 32 * nb, nullptr, nullptr, scr, F.lane); continue; } r -= NB;
        if (r < NC) { const int q = r / IC, s = r % IC, j = q >> 1, up = q & 1, kb = s / 88, nb = s % 88; const int n0 = 32 * nb;
            if (j == 1 && gridDim.x == 256) continue;
            p0_transpose_item((up ? a.ffn_wu : a.ffn_wg) + (size_t)j * D * FF, D, FF, (bf16*)(ws + WS_WGU) + (size_t)j * NGU * D, kb, nb, (n0 >> 7) * 256 + (n0 & 127) + up * 128, nullptr, nullptr, scr, F.lane); continue; } r -= NC;
        if (r < ND) { const int j = r / ID, s = r % ID, kb = s / 32, nb = s % 32;
            p0_transpose_item8(a.ffn_wd + (size_t)j * FF * D, FF, D, ws + WS_WD + (size_t)j * D * FF, kb, nb, 32 * nb, WD_SCALE, scr, F.lane); continue; } r -= ND;
        if (r < NEI) { const int q = r / IE, s = r % IE, je = q >> 1, up = q & 1, kb = s / 112, nb = s % 112; const int n0 = 32 * nb;
            p0_transpose_item8((up ? a.moe_wu : a.moe_wg) + (size_t)je * D * FE, D, FE, ws + WS_MGU + (size_t)je * NGUE * D, kb, nb, (n0 >> 7) * 256 + (n0 & 127) + up * 128, W1_SCALE, scr, F.lane); continue; } r -= NEI;
        if (r < NF) { const int je = r / IF, s = r % IF, kb = s / 32, nb = s % 32;
            p0_transpose_item8(a.moe_wd + (size_t)je * FE * D, FE, D, ws + WS_MD + (size_t)je * D * FE, kb, nb, 32 * nb, WD_SCALE, scr, F.lane); continue; } r -= NF;
        { const int q = r / IG, s = r % IG, j = 1, up = q & 1, kb = s / 88, nb = s % 88; const int n0 = 32 * nb;
            p0_transpose_item8((up ? a.ffn_wu : a.ffn_wg) + (size_t)j * D * FF, D, FF, ws + WS_WGU8 + (size_t)j * NGU * D, kb, nb, (n0 >> 7) * 256 + (n0 & 127) + up * 128, W1_SCALE, scr, F.lane); }
    }
    bf16* XB = (bf16*)(ws + WS_XB);
    for (int m0 = gw * 4; m0 < M; m0 += NGW * 4) {
        f32x4 v[4][4];
#pragma unroll
        for (int r = 0; r < 4; ++r) { const GAS f32x4* xr = (const GAS f32x4*)(a.x + (size_t)(m0 + r) * D) + F.lane;
#pragma unroll
            for (int j = 0; j < 4; ++j) v[r][j] = xr[64 * j]; }
#pragma unroll
        for (int r = 0; r < 4; ++r) { GAS unsigned long long* o8 = (GAS unsigned long long*)(XB + (size_t)(m0 + r) * D) + F.lane;
#pragma unroll
            for (int j = 0; j < 4; ++j) o8[64 * j] = (unsigned long long)pk2(v[r][j].x, v[r][j].y) | ((unsigned long long)pk2(v[r][j].z, v[r][j].w) << 32); } }
    float* cosb = (float*)(ws + WS_ROPE); float* sinb = cosb + (size_t)M * 4;
    for (int i = (F.vcu * NWAVES + F.wave) * 64 + F.lane; i < M * 4; i += NGW * 64) { const int row = i >> 2, j = i & 3;
        const float inv = (j == 0) ? 1.0f : (j == 1) ? 0.037606030930863934f : (j == 2) ? 0.0014142135623730950f : 5.3183958501313043e-05f;
        const float ang = (float)a.pos[row] * inv; cosb[i] = (float)cos((double)ang); sinb[i] = (float)sin((double)ang); }
}

__device__ __forceinline__ void v8t_items(const Args& a, Frame& F) {
    const bf16* Z = (const bf16*)(a.ws + WS_R + R_Z); unsigned char* V8 = a.ws + WS_V8T;
    int tl = F.tid; asm volatile("" : "+v"(tl)); const int lane = tl & 63;
    LAS unsigned char* scr = F.lds + RING_OFF + F.wave * 4096;
    const int kk = lane & 31, hi = (kk >> 2) & 1, r = (kk & 3) + 4 * (kk >> 3), p = hi * 32 + (lane >> 5) * 16 + r;
    LAS unsigned char* wp = scr + (p >> 4) * 1024 + (p & 15);
    const int gw = F.vcu * NWAVES + F.wave, NGW = F.G * NWAVES;
    for (int it = gw; it < BATCH * 4 * 128; it += NGW) { const int bh = it >> 7, tile = it & 127, b = bh >> 2, h = bh & 3;
        const v4u* src = (const v4u*)(a.ws + WS_V8R + (size_t)(b * SEQ + tile * 64 + lane) * 256 + h * 64);
        v4u v[4];
#pragma unroll
        for (int i = 0; i < 4; ++i) v[i] = src[i];
#pragma unroll
        for (int i = 0; i < 4; ++i) { const unsigned w4[4] = {v[i].x, v[i].y, v[i].z, v[i].w};
#pragma unroll
            for (int d = 0; d < 4; ++d)
#pragma unroll
                for (int q = 0; q < 4; ++q) wp[(16 * i + 4 * d + q) * 16] = (unsigned char)(w4[d] >> (8 * q)); }
        LDS_WAIT(); asm volatile("" ::: "memory");
        unsigned char* dst = V8 + ((size_t)bh * 128 + tile) * 4096;
#pragma unroll
        for (int i = 0; i < 4; ++i) *(GAS v4u*)(dst + (i * 64 + lane) * 16) = *(const LAS v4u*)(scr + (i * 64 + lane) * 16);
        LDS_WAIT(); asm volatile("" ::: "memory");
    }
}

__device__ __forceinline__ unsigned pk2c(float lo, float hi) { unsigned r; asm("v_cvt_pk_bf16_f32 %0, %1, %2" : "=v"(r) : "v"(lo), "v"(hi)); return r; }
__device__ __forceinline__ unsigned mul_bf2(unsigned g, unsigned h) { return pk2c(bflo(g) * bflo(h), bfhi(g) * bfhi(h)); }
__device__ __forceinline__ float sigm(float x) { return __builtin_amdgcn_rcpf(1.0f + __builtin_amdgcn_exp2f(x * -1.4426950408889634f)); }
__device__ __forceinline__ unsigned glu_bf2(unsigned ca, unsigned cg) { return pk2c(bflo(ca) * sigm(bflo(cg)), bfhi(ca) * sigm(bfhi(cg))); }
__device__ __forceinline__ void mixer_items(const Args& a, Frame& F, int l, int item0, int stride) {
    const bf16* Z = (const bf16*)(a.ws + WS_R + R_Z); bf16* Y = (bf16*)(a.ws + WS_R + R_Y);
    const v4u zero4 = (v4u){0u, 0u, 0u, 0u};
#define MX_SYNC() asm volatile("s_waitcnt lgkmcnt(0)\n\ts_barrier" ::: "memory")
    v4u pin[5];
#define MX_LOAD_POOL(it_) do { int tq = F.tid; asm volatile("" : "+v"(tq)); const int t0q = (it_) * 64, s0q = t0q & (SEQ - 1); \
        _Pragma("unroll") for (int i = 0; i < 5; ++i) { const int c = tq + 512 * i, r = c >> 5, k = c & 31; pin[i] = zero4; if (c < 79 * 32 && s0q - 15 + r >= 0) pin[i] = *(const v4u*)(Z + (size_t)(t0q - 15 + r) * ZW + k * 8); } } while (0)
    float wdj[31]; { int tq = F.tid; asm volatile("" : "+v"(tq)); const float* wd = a.conf_dw + (size_t)l * 31 * 256 + (tq & 255);
#pragma unroll
        for (int j = 0; j < 31; ++j) wdj[j] = wd[j * 256]; }
    if (item0 < M / 64) MX_LOAD_POOL(item0);
    for (int item = item0; item < M / 64; item += stride) {
    int tl = F.tid; asm volatile("" : "+v"(tl));
    const int ch = tl & 255, rh = tl >> 8;
    const int t0 = item * 64, s0 = t0 & (SEQ - 1);
    LAS unsigned char* L = F.lds;
    LAS bf16* IN = (LAS bf16*)L; LAS bf16* OUTA = (LAS bf16*)(L + 40448); LAS bf16* P = (LAS bf16*)(L + 73216); LAS bf16* SBt = (LAS bf16*)(L + 107008);
    LAS bf16* OUTB = (LAS bf16*)L; LAS bf16* U = (LAS bf16*)(L + 32768); LAS float* cv = (LAS float*)(L + 80896);
#pragma unroll
    for (int i = 0; i < 5; ++i) { const int c = tl + 512 * i, r = c >> 5, k = c & 31; if (c < 79 * 32) *(LAS v4u*)(IN + r * 256 + k * 8) = pin[i]; }
    MX_SYNC();
    v4u sp[5], sbv[4];
#pragma unroll
    for (int i = 0; i < 5; ++i) { const int c = tl + 512 * i, r = c >> 5, k = c & 31; sp[i] = zero4;
        if (c < 66 * 32 && s0 - 2 + r >= 0) sp[i] = *(const v4u*)(Z + (size_t)(t0 - 2 + r) * ZW + 512 + k * 8); }
#pragma unroll
    for (int i = 0; i < 4; ++i) { const int c = tl + 512 * i, r = c >> 5, k = c & 31; sbv[i] = *(const v4u*)(Z + (size_t)(t0 + r) * ZW + 256 + k * 8); }
    {
        const int w = 2 << (ch >> 6); const LAS bf16* ic = IN + (rh * 32) * 256 + ch;
        float v[47];
#pragma unroll
        for (int i = 0; i < 47; ++i) v[i] = bf2f(ic[i * 256]);
        LAS bf16* oc = OUTA + (rh * 32) * 256 + ch; const int sb = s0 + rh * 32;
#define MX_POOL(W) do { float acc = 0.f; _Pragma("unroll") for (int j = 1; j < (W); ++j) acc += v[15 - j]; \
        _Pragma("unroll") for (int i = 0; i < 32; ++i) { const int s = sb + i; acc += v[15 + i]; \
            const float rc = (s + 1 < (W)) ? __builtin_amdgcn_rcpf((float)(s + 1)) : (1.0f / (float)(W)); const float ov = acc * rc - v[15 + i]; oc[i * 256] = (bf16)pk2c(ov, ov); \
            acc -= v[16 + i - (W)]; } } while (0)
        if (w == 2) MX_POOL(2); else if (w == 4) MX_POOL(4); else if (w == 8) MX_POOL(8); else MX_POOL(16);
#undef MX_POOL
    }
#pragma unroll
    for (int i = 0; i < 5; ++i) { const int c = tl + 512 * i, r = c >> 5, k = c & 31; if (c < 66 * 32) *(LAS v4u*)(P + r * 256 + k * 8) = sp[i]; }
#pragma unroll
    for (int i = 0; i < 4; ++i) { const int c = tl + 512 * i, r = c >> 5, k = c & 31; *(LAS v4u*)(SBt + r * 256 + k * 8) = sbv[i]; }
    MX_SYNC();
#pragma unroll
    for (int i = 0; i < 4; ++i) { const int c = tl + 512 * i, r = c >> 5, k = c & 31; *(v4u*)(Y + (size_t)(t0 + r) * D + k * 8) = *(const LAS v4u*)(OUTA + r * 256 + k * 8); }
    v4u cuv[6];
#pragma unroll
    for (int i = 0; i < 6; ++i) { const int c = tl + 512 * i, r = c >> 5, k = c & 31; cuv[i] = zero4;
        if (c < 94 * 32 && s0 - 30 + r >= 0) cuv[i] = *(const v4u*)(Z + (size_t)(t0 - 30 + r) * ZW + 1024 + k * 8); }
    {
        const float* wc = a.sconv_w + (size_t)l * 3 * 256 + ch; const float w0 = wc[0], w1 = wc[256], w2 = wc[512];
        const LAS bf16* pc = P + (rh * 32) * 256 + ch; const LAS bf16* sc = SBt + (rh * 32) * 256 + ch; LAS bf16* oc = OUTB + (rh * 32) * 256 + ch;
        float p[34];
#pragma unroll
        for (int i = 0; i < 34; ++i) p[i] = bf2f(pc[i * 256]);
#pragma unroll
        for (int i = 0; i < 32; ++i) { const float ov = bf2f(sc[i * 256]) * (w0 * p[i] + w1 * p[i + 1] + w2 * p[i + 2]); oc[i * 256] = (bf16)pk2c(ov, ov); }
    }
    MX_SYNC();
#pragma unroll
    for (int i = 0; i < 6; ++i) { const int c = tl + 512 * i, r = c >> 5, k = c & 31; if (c < 94 * 32) *(LAS v4u*)(U + r * 256 + k * 8) = cuv[i]; }
#pragma unroll
    for (int i = 0; i < 4; ++i) { const int c = tl + 512 * i, r = c >> 5, k = c & 31; *(v4u*)(Y + (size_t)(t0 + r) * D + 256 + k * 8) = *(const LAS v4u*)(OUTB + r * 256 + k * 8); }
    MX_SYNC();
    {
        const LAS bf16* uc = U + (rh * 32) * 256 + ch;
        if (item + stride < M / 64) MX_LOAD_POOL(item + stride);
        float u[62];
#pragma unroll
        for (int i = 0; i < 62; ++i) u[i] = bf2f(uc[i * 256]);
        float o[32];
#pragma unroll
        for (int i = 0; i < 32; ++i) o[i] = 0.f;
#pragma unroll
        for (int j = 0; j < 31; ++j) { const float wj = wdj[j];
#pragma unroll
            for (int i = 0; i < 32; ++i) o[i] += wj * u[i + j]; }
#pragma unroll
        for (int i = 0; i < 32; ++i) cv[(rh * 32 + i) * 256 + ch] = o[i];
        MX_SYNC();
        int ll = F.lane; asm volatile("" : "+v"(ll));
        const f32x4 gv = *(const f32x4*)(a.conf_g + l * 256 + 4 * ll), bv = *(const f32x4*)(a.conf_b + l * 256 + 4 * ll);
        f32x4 v8[8]; float s8[8], q8[8];
#pragma unroll
        for (int i = 0; i < 8; ++i) { v8[i] = *(const LAS f32x4*)(cv + (F.wave * 8 + i) * 256 + 4 * ll); const f32x4 v = v8[i];
            s8[i] = (v.x + v.y) + (v.z + v.w); q8[i] = (v.x * v.x + v.y * v.y) + (v.z * v.z + v.w * v.w); }
#pragma unroll
        for (int o = 1; o < 64; o <<= 1) {
#pragma unroll
            for (int i = 0; i < 8; ++i) { s8[i] += __shfl_xor(s8[i], o); q8[i] += __shfl_xor(q8[i], o); } }
#pragma unroll
        for (int i = 0; i < 8; ++i) { const int r = F.wave * 8 + i; const float mean = s8[i] * (1.f / 256.f); const float var = __builtin_fmaxf(q8[i] * (1.f / 256.f) - mean * mean, 0.f);
            const float rstd = __builtin_amdgcn_rsqf(var + LN_EPS);
            f32x4 y = (v8[i] - mean) * rstd * gv + bv;
#pragma unroll
            for (int q = 0; q < 4; ++q) y[q] = y[q] * sigm(y[q]);
            v2u o2; o2.x = pk2c(y.x, y.y); o2.y = pk2c(y.z, y.w);
            *(v2u*)(Y + (size_t)(t0 + r) * D + 768 + 4 * ll) = o2; }
        MX_SYNC();
    }
    }
#undef MX_LOAD_POOL
#undef MX_SYNC
}

__device__ __forceinline__ int moe_setup(Frame& F, int jmoe);
__device__ __forceinline__ void wave_sum4(float (&v)[4]) {
#pragma unroll
    for (int o = 1; o < 64; o <<= 1) {
#pragma unroll
        for (int r = 0; r < 4; ++r) v[r] += __shfl_xor(v[r], o); }
}
template <int MODE, bool FINAL>
__device__ __forceinline__ void ln_pass(const Args& a, Frame& F, const float* gam, const float* bet, int jmoe, int tile0) {
    bf16* XB = (bf16*)(a.ws + WS_XB);
    { int t_ = F.tid; asm volatile("" : "+v"(t_)); F.tid = t_; F.lane = t_ & 63; }
    LAS float* wr = (LAS float*)(F.lds + RING_OFF);
    LAS int* sel = (LAS int*)(F.lds + RING_OFF + 32768);
    int4* tok = (int4*)(a.ws + WS_TOK); int* list = (int*)(a.ws + WS_LIST);
    gu32* cnt = F.ctl + CW_CNT + jmoe * 8 * 64;
    const LAS int* ub = (const LAS int*)(F.lds + RUEXP_OFF + 640);
    if (MODE == 1) { const float* rw = a.router + (size_t)jmoe * D * NE;
        for (int i = F.tid; i < D * NE; i += NWAVES * 64) { const int col = i >> 3, e = i & 7, ln = (col & 255) >> 2, q = col & 3, j = col >> 8; wr[((((j * 4 + q) * 2 + (e >> 2)) * 64 + ln) << 2) + (e & 3)] = rw[i]; }
        __syncthreads(); }
    if (MODE == 2) { (void)moe_setup(F, jmoe); }
    f32x4 gv[4], bv[4];
#pragma unroll
    for (int j = 0; j < 4; ++j) { gv[j] = *(const f32x4*)(gam + 4 * F.lane + 256 * j); bv[j] = *(const f32x4*)(bet + 4 * F.lane + 256 * j); }
    const bf16* Fb = (const bf16*)(a.ws + WS_R + R_F);
    for (int tile = tile0; tile < M / 256; tile += F.G) {
        for (int rr = 0; rr < 32; rr += 4) {
            const int row0 = tile * 256 + F.wave * 32 + rr;
            f32x4 v[4][4];
#pragma unroll
            for (int r = 0; r < 4; ++r) { const GAS v2u* xr = (const GAS v2u*)(XB + (size_t)(row0 + r) * D) + F.lane;
#pragma unroll
                for (int j = 0; j < 4; ++j) { const v2u q = xr[64 * j]; v[r][j] = (f32x4){bflo(q.x), bfhi(q.x), bflo(q.y), bfhi(q.y)}; } }
            if (MODE == 2) {
                int4 ti[4];
#pragma unroll
                for (int r = 0; r < 4; ++r) ti[r] = tok[row0 + r];
#pragma unroll
                for (int r = 0; r < 4; ++r) { const float w1 = __builtin_bit_cast(float, ti[r].z), w2 = __builtin_bit_cast(float, ti[r].w);
                    const size_t p1 = (size_t)(ub[ti[r].x >> 16] * 256 + (ti[r].x & 0xffff)), p2 = (size_t)(ub[ti[r].y >> 16] * 256 + (ti[r].y & 0xffff));
                    const v2u* f1 = (const v2u*)(Fb + p1 * D) + F.lane; const v2u* f2 = (const v2u*)(Fb + p2 * D) + F.lane;
#pragma unroll
                    for (int j = 0; j < 4; ++j) { const v2u q1 = f1[64 * j], q2 = f2[64 * j];
                        v[r][j].x = DN_ALPHA * v[r][j].x + (w1 * bflo(q1.x) + w2 * bflo(q2.x)); v[r][j].y = DN_ALPHA * v[r][j].y + (w1 * bfhi(q1.x) + w2 * bfhi(q2.x));
                        v[r][j].z = DN_ALPHA * v[r][j].z + (w1 * bflo(q1.y) + w2 * bflo(q2.y)); v[r][j].w = DN_ALPHA * v[r][j].w + (w1 * bfhi(q1.y) + w2 * bfhi(q2.y)); } }
            }
            float s[4];
#pragma unroll
            for (int r = 0; r < 4; ++r) { s[r] = 0.f;
#pragma unroll
                for (int j = 0; j < 4; ++j) s[r] += (v[r][j].x + v[r][j].y) + (v[r][j].z + v[r][j].w); }
            wave_sum4(s);
            float s2[4];
#pragma unroll
            for (int r = 0; r < 4; ++r) { const float mean = s[r] * (1.f / D); s2[r] = 0.f;
#pragma unroll
                for (int j = 0; j < 4; ++j) { v[r][j] = v[r][j] - mean; s2[r] += (v[r][j].x * v[r][j].x + v[r][j].y * v[r][j].y) + (v[r][j].z * v[r][j].z + v[r][j].w * v[r][j].w); } }
            wave_sum4(s2);
#pragma unroll
            for (int r = 0; r < 4; ++r) { const float rstd = __builtin_amdgcn_rsqf(s2[r] * (1.f / D) + LN_EPS);
                GAS f32x4* xr = (GAS f32x4*)(a.out + (size_t)(row0 + r) * D) + F.lane; GAS unsigned long long* o8 = (GAS unsigned long long*)(XB + (size_t)(row0 + r) * D) + F.lane;
#pragma unroll
                for (int j = 0; j < 4; ++j) { v[r][j] = v[r][j] * rstd * gv[j] + bv[j]; if (FINAL) xr[64 * j] = v[r][j]; else o8[64 * j] = (unsigned long long)pk2(v[r][j].x, v[r][j].y) | ((unsigned long long)pk2(v[r][j].z, v[r][j].w) << 32);
                    if (MODE == 1) ((GAS unsigned*)(a.ws + WS_XB8 + (size_t)(row0 + r) * D))[F.lane + 64 * j] = (unsigned)__builtin_amdgcn_cvt_pk_fp8_f32(v[r][j].z, v[r][j].w, __builtin_amdgcn_cvt_pk_fp8_f32(v[r][j].x, v[r][j].y, 0, false), true); } }
            if (MODE == 1) {
#pragma unroll
                for (int r = 0; r < 4; ++r) {
                    float lg[NE];
#pragma unroll
                    for (int e = 0; e < NE; ++e) lg[e] = 0.f;
#pragma unroll
                    for (int j = 0; j < 4; ++j)
#pragma unroll
                        for (int q = 0; q < 4; ++q) { const LAS f32x4* w4 = (const LAS f32x4*)wr + ((j * 4 + q) * 2) * 64 + F.lane; const f32x4 wa = w4[0], wb = w4[64]; const float xv = v[r][j][q];
                            lg[0] += xv * wa.x; lg[1] += xv * wa.y; lg[2] += xv * wa.z; lg[3] += xv * wa.w; lg[4] += xv * wb.x; lg[5] += xv * wb.y; lg[6] += xv * wb.z; lg[7] += xv * wb.w; }
                    float h4[4], h2[2], h1;
                    { const bool up = (F.lane & 32) != 0;
#pragma unroll
                      for (int e = 0; e < 4; ++e) { const float keep = up ? lg[e + 4] : lg[e], give = up ? lg[e] : lg[e + 4]; h4[e] = keep + __shfl_xor(give, 32); } }
                    { const bool up = (F.lane & 16) != 0;
#pragma unroll
                      for (int e = 0; e < 2; ++e) { const float keep = up ? h4[e + 2] : h4[e], give = up ? h4[e] : h4[e + 2]; h2[e] = keep + __shfl_xor(give, 16); } }
                    { const bool up = (F.lane & 8) != 0; const float keep = up ? h2[1] : h2[0], give = up ? h2[0] : h2[1]; h1 = keep + __shfl_xor(give, 8); }
                    h1 += __shfl_xor(h1, 4); h1 += __shfl_xor(h1, 2); h1 += __shfl_xor(h1, 1);
                    float le[NE];
#pragma unroll
                    for (int e = 0; e < NE; ++e) le[e] = __builtin_bit_cast(float, __builtin_amdgcn_readlane(__builtin_bit_cast(int, h1), e * 8));
                    int i1 = 0; float m1 = le[0];
#pragma unroll
                    for (int e = 1; e < NE; ++e) if (le[e] > m1) { m1 = le[e]; i1 = e; }
                    int i2 = -1; float m2 = -INFINITY;
#pragma unroll
                    for (int e = 0; e < NE; ++e) if (e != i1 && (i2 < 0 || le[e] > m2)) { m2 = le[e]; i2 = e; }
                    const float w1 = 1.0f / (1.0f + expf(m2 - m1)), w2 = 1.0f - w1;
                    if (F.lane == 0) { LAS int* sp = sel + (F.wave * 32 + rr + r) * 4; sp[0] = i1; sp[1] = i2; sp[2] = __builtin_bit_cast(int, w1); sp[3] = __builtin_bit_cast(int, w2); }
                }
            }
        }
        if (MODE == 1) {
            __syncthreads();
            if (F.tid < 256) {
                const int token = tile * 256 + F.tid; const LAS int* sp = sel + F.tid * 4; const int e1 = sp[0], e2 = sp[1]; int slot1 = 0, slot2 = 0;
#pragma unroll
                for (int e = 0; e < NE; ++e) {
                    const bool mine = (e1 == e) || (e2 == e); const unsigned long long mk = __ballot(mine);
                    if (mk != 0ull) { const int leader = __builtin_ctzll(mk); unsigned base = 0u;
                        if (F.lane == leader) base = __hip_atomic_fetch_add(cnt + e * 64, (unsigned)__builtin_popcountll(mk), RLX_AGENT);
                        base = (unsigned)__shfl((int)base, leader);
                        const int my = (int)base + __builtin_popcountll(mk & ((1ull << F.lane) - 1ull));
                        if (e1 == e) slot1 = my; if (e2 == e) slot2 = my; }
                }
                list[e1 * M + slot1] = token; list[e2 * M + slot2] = token;
                tok[token] = make_int4((e1 << 16) | slot1, (e2 << 16) | slot2, sp[2], sp[3]);
            }
            __syncthreads();
        }
    }
}

__device__ __forceinline__ void xb8_pass(const Args& a, Frame& F) {
    { int t_ = F.tid; asm volatile("" : "+v"(t_)); F.tid = t_; F.lane = t_ & 63; }
    const bf16* XB = (const bf16*)(a.ws + WS_XB); unsigned char* X8 = a.ws + WS_XB8;
    const int gw = F.vcu * NWAVES + F.wave, NGW = F.G * NWAVES;
    for (int m0 = gw * 4; m0 < M; m0 += NGW * 4) {
        v2u q[4][4];
#pragma unroll
        for (int r = 0; r < 4; ++r) { const GAS v2u* xr = (const GAS v2u*)(XB + (size_t)(m0 + r) * D) + F.lane;
#pragma unroll
            for (int j = 0; j < 4; ++j) q[r][j] = xr[64 * j]; }
#pragma unroll
        for (int r = 0; r < 4; ++r)
#pragma unroll
            for (int j = 0; j < 4; ++j) ((GAS unsigned*)(X8 + (size_t)(m0 + r) * D))[F.lane + 64 * j] =
                (unsigned)__builtin_amdgcn_cvt_pk_fp8_f32(bflo(q[r][j].y), bfhi(q[r][j].y), __builtin_amdgcn_cvt_pk_fp8_f32(bflo(q[r][j].x), bfhi(q[r][j].x), 0, false), true);
    }
}
template <bool GATHER_> struct MoeOrder {
    static constexpr bool GATHER = GATHER_;
    int nru, nN, G, c, ru0, split, skip, ns; const LAS unsigned char* ruexp; const LAS unsigned short* rowtab;
    __device__ __forceinline__ int ru(int pm) const { return ru0 + pm + (pm >= split ? skip : 0); }
    __device__ __forceinline__ bool next(int i, pg8::Unit& u) const { int pm, pn; int cc = c, ii = i;
        if (ns > 0) { if (c < ns) { if (i >= 25) return false; } else if (c < 4 * ns && i == 28) { const int d = c - ns; cc = d % ns; ii = 25 + d / ns; } }
        if (!pg8::static_unit(nru, nN, G, cc, ii, pm, pn)) return false;
        const int e = __builtin_amdgcn_readfirstlane((int)ruexp[ru(pm)]); u.pm = pm; u.pn = pn; u.pb = e * nN + pn; return true; }
    __device__ __forceinline__ unsigned a_row(int ui, const pg8::Unit& u, int r) const { return GATHER_ ? (unsigned)rowtab[ui * 256 + r] : (unsigned)(u.pm * 256 + r); }
};
__device__ __forceinline__ int moe_setup(Frame& F, int jmoe) {
    gu32* cnt = F.ctl + CW_CNT + jmoe * 8 * 64; LAS unsigned char* ruexp = (LAS unsigned char*)(F.lds + RUEXP_OFF); LAS int* ub = (LAS int*)(F.lds + RUEXP_OFF + 640); LAS int* cn = ub + 8;
    int ubase[NE]; int acc = 0;
#pragma unroll
    for (int e = 0; e < NE; ++e) { const unsigned c = __hip_atomic_load(cnt + e * 64, RLX_AGENT); ubase[e] = acc; acc += (int)((c + 255u) >> 8); if (F.tid == 0) { ub[e] = ubase[e]; cn[e] = (int)c; } }
    const int U = acc < MOE_MAXU ? acc : MOE_MAXU;
    for (int ru = F.tid; ru < 640; ru += NWAVES * 64) { int e = 0;
#pragma unroll
        for (int q = 1; q < NE; ++q) if (ru >= ubase[q]) e = q;
        ruexp[ru] = (unsigned char)e; }
    __syncthreads();
    return U;
}
constexpr int STEPS_PER_LAYER = 6 + MOE_SEAMS;
constexpr int NSTEPS = 1 + DEPTH * STEPS_PER_LAYER;
#ifndef UP8_MASK
#define UP8_MASK 4
#endif
__device__ __forceinline__ float lam_init_of(int l) { return l == 0 ? 0.2f : l == 1 ? 0.35550906759096926f : l == 2 ? 0.47071301834358416f : 0.5560582041556405f; }

typedef const __attribute__((address_space(4))) Args* kargs_t;
#if defined(__HIP_DEVICE_COMPILE__)
__device__ __forceinline__ Args load_args(kargs_t p) { asm volatile("" : "+s"(p)); return *p; }
#else
__device__ __forceinline__ Args load_args(kargs_t) { return Args{}; }
#endif
__device__ __forceinline__ Frame make_frame(unsigned char* lds, unsigned char* ws) {
    Frame F; F.lds = (LAS unsigned char*)lds; F.tid = threadIdx.x; F.lane = F.tid & 63; F.wave = __builtin_amdgcn_readfirstlane(F.tid >> 6);
    F.G = gridDim.x; { const int bx = blockIdx.x; F.vcu = (F.G % 8 == 0) ? (bx % 8) * (F.G / 8) + bx / 8 : bx; }
    F.ctl = (gu32*)(ws + WS_CTL); return F;
}
__global__ void __launch_bounds__(NWAVES * 64, 2) fwd(Args a_in) {
    extern __shared__ __attribute__((aligned(16))) unsigned char lds[];
    const kargs_t ap = (kargs_t)__builtin_amdgcn_kernarg_segment_ptr();
    volatile LAS unsigned* MISC = (volatile LAS unsigned*)((LAS unsigned char*)lds + MISC_OFF);
    for (int u = threadIdx.x; u < 64; u += NWAVES * 64) MISC[u] = 0u;
    __syncthreads();
    const int lo = a_in.ph_lo, hi = a_in.ph_hi;
    if (hi - lo > 1) { (void)xcd_barrier_post((unsigned*)(a_in.ws + WS_CTL) + CW_BAR, MISC + 8); }
    int step = 0;
    const bool fuse_ln = (gridDim.x == 256);
#define IN() (lo <= step && step < hi)
#define SEAM() do { if (lo <= step && step + 1 < hi) { XcdBarrier bar_; bar_.bar = (unsigned*)(load_args(ap).ws + WS_CTL) + CW_BAR; bar_.x = xb_xcc_id(); bar_.st = MISC + 8; xcd_barrier(bar_); } ++step; } while (0)
#define SITE() const Args a = load_args(ap); unsigned char* ws = a.ws; Frame F = make_frame(lds, ws); LAS unsigned char* ring = F.lds + RING_OFF; const int cblk = (int)blockIdx.x; \
    bf16* XB = (bf16*)(ws + WS_XB); bf16* Zb = (bf16*)(ws + WS_R + R_Z); bf16* Yb = (bf16*)(ws + WS_R + R_Y); bf16* Hb = (bf16*)(ws + WS_R + R_H); bf16* HM = (bf16*)(ws + WS_R + R_HM); bf16* Fb = (bf16*)(ws + WS_R + R_F); \
    const float* cosb = (const float*)(ws + WS_ROPE); const float* sinb = cosb + (size_t)M * 4; (void)XB; (void)Zb; (void)Yb; (void)Hb; (void)HM; (void)Fb; (void)cosb; (void)sinb; (void)ring; (void)cblk

    if (IN()) { SITE(); p0_prologue(a, F);
    }
    SEAM();

    for (int l = 0; l < DEPTH; ++l) {
        const int jh = l >> 1; const bool moe = (l & 1) != 0;
        const bool up8 = fuse_ln && !moe && ((UP8_MASK >> l) & 1);
        if (IN()) { SITE();
            pg8::Gemm g{XB, (const bf16*)(ws + WS_WIN) + (size_t)l * NZ * D, D}; pg8::StaticOrder S{M / 256, NZ / 256, F.G, cblk};
            pg8::EpiZ E{Zb, ZW, cosb, sinb, attn_body::C2, ws + WS_V8T, ws + WS_KT};
            pg8::gemm_phase<pg8::EpiZ, pg8::StaticOrder>(ring, g, S, E);
        }
        SEAM();
        if (IN()) { SITE();
            mixer_items(a, F, l, F.vcu, F.G);
        }
        ++step;
        if (IN()) { SITE();
            float lam;
            { const float* lp = a.dlam + l * 128; float p1 = 0.f, p2 = 0.f; if (F.lane < 32) { p1 = lp[F.lane] * lp[32 + F.lane]; p2 = lp[64 + F.lane] * lp[96 + F.lane]; }
              lam = expf(wave_sum(p1)) - expf(wave_sum(p2)) + lam_init_of(l); }
            attn_body::AttnParams P{(const attn_body::bf16*)Zb, (attn_body::bf16*)Yb, lam, 1.0f - lam_init_of(l), a.subg + l * 64, ws + WS_V8T, ws + WS_KT};
            attn_body::attn_phase<4>((char*)lds + RING_OFF, P, F.vcu, F.G);
        }
        SEAM();
        if (IN()) { SITE();
            pg8::Gemm g{Yb, (const bf16*)(ws + WS_WO) + (size_t)l * D * D, D}; pg8::StaticOrder S{M / 256, D / 256, F.G, cblk};
            if (fuse_ln && !moe) {
                pg8::EpiResLN E{XB, D, DN_ALPHA, 1.f, a.ln1_g + l * D, a.ln1_b + l * D, (unsigned long long*)(ws + WS_XLN), (unsigned*)(ws + WS_CTL) + CW_LNC, 32u * (unsigned)(2 * jh + 1), (unsigned*)(ws + WS_CTL) + CW_TMO, F.lds + LNTAB_OFF};
                pg8::gemm_phase<pg8::EpiResLN, pg8::StaticOrder>(ring, g, S, E);
            } else {
                pg8::EpiRes E{XB, D, DN_ALPHA, 1.f};
                pg8::gemm_phase<pg8::EpiRes, pg8::StaticOrder>(ring, g, S, E);
            }
        }
        SEAM();
        if (moe || !fuse_ln) {
            if (IN()) { SITE(); if (moe) ln_pass<1, false>(a, F, a.ln1_g + l * D, a.ln1_b + l * D, jh, F.vcu);
                else ln_pass<0, false>(a, F, a.ln1_g + l * D, a.ln1_b + l * D, jh, F.vcu); }
            SEAM();
        } else if (up8) { if (IN()) { SITE(); xb8_pass(a, F); } SEAM(); }
        else ++step;
        if (!moe) {
            if (up8) { if (IN()) { SITE();
                pg8::StaticOrder S{M / 256, NGU / 256, F.G, cblk};
                pg8::Gemm g{(const bf16*)(ws + WS_XB8), (const bf16*)(ws + WS_WGU8 + (size_t)jh * NGU * D), D};
                pg8::EpiSwiGLU8 E{(unsigned char*)Hb, FF, 1.f / W1_SCALE, H_SCALE};
                pg8::gemm_phase<pg8::EpiSwiGLU8, pg8::StaticOrder, true>(ring, g, S, E); } }
            else { if (IN()) { SITE();
                pg8::StaticOrder S{M / 256, NGU / 256, F.G, cblk};
                pg8::Gemm g{XB, (const bf16*)(ws + WS_WGU) + (size_t)jh * NGU * D, D};
                pg8::EpiSwiGLU8 E{(unsigned char*)Hb, FF, 1.f, H_SCALE};
                pg8::gemm_phase<pg8::EpiSwiGLU8, pg8::StaticOrder>(ring, g, S, E); } }
            SEAM();
            if (IN()) { SITE();
                pg8::Gemm g{Hb, (const bf16*)(ws + WS_WD + (size_t)jh * D * FF), FF}; pg8::StaticOrder S{M / 256, D / 256, F.G, cblk};
                if (fuse_ln) {
                    pg8::EpiResLN E{XB, D, DN_ALPHA, 1.f / (H_SCALE * WD_SCALE), a.ln2_g + l * D, a.ln2_b + l * D, (unsigned long long*)(ws + WS_XLN), (unsigned*)(ws + WS_CTL) + CW_LNC, 32u * (unsigned)(2 * jh + 2), (unsigned*)(ws + WS_CTL) + CW_TMO, F.lds + LNTAB_OFF};
                    pg8::gemm_phase<pg8::EpiResLN, pg8::StaticOrder, true>(ring, g, S, E);
                } else {
                    pg8::EpiRes E{XB, D, DN_ALPHA, 1.f / (H_SCALE * WD_SCALE)};
                    pg8::gemm_phase<pg8::EpiRes, pg8::StaticOrder, true>(ring, g, S, E);
                }
            }
            SEAM();
            step += MOE_SEAMS - 2;
        } else {
#pragma nounroll
            for (int k = 0; k < 5; ++k) {
                const bool isup = (k == 0 || k == 2);
                if (isup) {
                    if (IN()) { SITE();
                        const int U = moe_setup(F, jh); const int rem = U - 2 * MOE_CH;
                        const LAS unsigned char* ruexp = (const LAS unsigned char*)(F.lds + RUEXP_OFF); const LAS int* ub = (const LAS int*)(F.lds + RUEXP_OFF + 640); const LAS int* cn = ub + 8;
                        LAS unsigned short* rowtab = (LAS unsigned short*)(F.lds + ROWTAB_OFF); const int* list = (const int*)(ws + WS_LIST);
                        MoeOrder<true> S{k == 0 ? MOE_CH + rem : MOE_CH, NGUE / 256, F.G, cblk, k == 0 ? 0 : MOE_CH, k == 0 ? MOE_CH : (1 << 30), k == 0 ? MOE_CH : 0, (k == 2 && F.G == 256) ? 4 * rem : 0, ruexp, rowtab};
                        for (int ui = 0; ui < 29; ++ui) { pg8::Unit u; if (!S.next(ui, u)) break;
                            if (F.tid < 256) { const int ru = S.ru(u.pm), e = (int)ruexp[ru], jj = (ru - ub[e]) * 256 + F.tid; rowtab[ui * 256 + F.tid] = (unsigned short)((jj < cn[e]) ? list[(size_t)e * M + jj] : 0); } }
                        __syncthreads();
                        pg8::Gemm g{(const bf16*)(ws + WS_XB8), (const bf16*)(ws + WS_MGU + (size_t)jh * NE * NGUE * D), D};
                        pg8::EpiSwiGLU8 E{(unsigned char*)HM, FE, 1.f / W1_SCALE, H_SCALE};
                        pg8::gemm_phase<pg8::EpiSwiGLU8, MoeOrder<true>, true>(ring, g, S, E);
                    }
                    if (k == 0) SEAM();
                } else {
                    if (IN()) { SITE();
                        const int U = moe_setup(F, jh); const int rem = U - 2 * MOE_CH;
                        const int nru = (k == 3) ? rem : MOE_CH; const int ru0 = (k == 1) ? 0 : (k == 3) ? 2 * MOE_CH : MOE_CH; const int hrow0 = (k == 3) ? MOE_CH * 256 : 0;
                        if (nru > 0) {
                            const LAS unsigned char* ruexp = (const LAS unsigned char*)(F.lds + RUEXP_OFF); const LAS unsigned short* rowtab = (const LAS unsigned short*)(F.lds + ROWTAB_OFF);
                            MoeOrder<false> S{nru, D / 256, F.G, cblk, ru0, (1 << 30), 0, 0, ruexp, rowtab};
                            pg8::Gemm g{(const bf16*)((const unsigned char*)HM + (size_t)hrow0 * FE), (const bf16*)(ws + WS_MD + (size_t)jh * NE * D * FE), FE};
                            pg8::EpiBf<false> E{Fb, D, ru0 * 256, nullptr, nullptr, -1, -1, 1.f, 1.f / (H_SCALE * WD_SCALE)};
                            pg8::gemm_phase<pg8::EpiBf<false>, MoeOrder<false>, true>(ring, g, S, E);
                        }
                    }
                    SEAM();
                }
            }
        }
        if (!moe && fuse_ln) { ++step; continue; }
        if (IN()) { SITE(); if (!moe) ln_pass<0, false>(a, F, a.ln2_g + l * D, a.ln2_b + l * D, jh, F.vcu); else if (l == DEPTH - 1) ln_pass<2, true>(a, F, a.ln2_g + l * D, a.ln2_b + l * D, jh, F.vcu); else ln_pass<2, false>(a, F, a.ln2_g + l * D, a.ln2_b + l * D, jh, F.vcu); }
        SEAM();
    }
#undef IN
#undef SEAM
#undef SITE
}
extern "C" void kernel_launch(void* const* d_in, const int* in_sizes, int n_in, void* d_out, int out_size, void* d_ws, size_t ws_size, hipStream_t stream) {
    static int grid = 0;
    if (grid == 0) {
        if (n_in != 23 || in_sizes[0] != M * D || out_size != M * D || ws_size < WS_NEED) { fprintf(stderr, "kernel_launch: unexpected shapes / workspace (n_in %d, ws %zu, need %zu); nothing launched\n", n_in, ws_size, (size_t)WS_NEED); grid = -1; return; }
        int dev = 0, cus = 0, per_cu = 0;
        if (hipGetDevice(&dev) != hipSuccess || hipDeviceGetAttribute(&cus, hipDeviceAttributeMultiprocessorCount, dev) != hipSuccess) { grid = -1; return; }
        if (hipFuncSetAttribute((const void*)fwd, hipFuncAttributeMaxDynamicSharedMemorySize, LDS_BYTES) != hipSuccess) { fprintf(stderr, "kernel_launch: hipFuncSetAttribute failed\n"); grid = -1; return; }
        if (hipOccupancyMaxActiveBlocksPerMultiprocessor(&per_cu, (const void*)fwd, NWAVES * 64, LDS_BYTES) != hipSuccess || per_cu < 1) fprintf(stderr, "kernel_launch: occupancy query says %d\n", per_cu);
        (void)hipGetLastError();
        grid = cus;
    }
    if (grid < 0) return;
    (void)hipMemsetAsync((char*)d_ws + WS_CTL, 0, CTL_ZERO_BYTES, stream);
    Args a{};
    a.x = (const float*)d_in[0]; a.pos = (const int*)d_in[1]; a.w_in = (const float*)d_in[2]; a.w_o = (const float*)d_in[3]; a.pool_w = (const float*)d_in[4]; a.pool_scale = (const float*)d_in[5];
    a.sconv_w = (const float*)d_in[6]; a.dlam = (const float*)d_in[7]; a.subg = (const float*)d_in[8]; a.conf_dw = (const float*)d_in[9]; a.conf_g = (const float*)d_in[10]; a.conf_b = (const float*)d_in[11];
    a.ln1_g = (const float*)d_in[12]; a.ln1_b = (const float*)d_in[13]; a.ln2_g = (const float*)d_in[14]; a.ln2_b = (const float*)d_in[15];
    a.ffn_wg = (const float*)d_in[16]; a.ffn_wu = (const float*)d_in[17]; a.ffn_wd = (const float*)d_in[18]; a.router = (const float*)d_in[19];
    a.moe_wg = (const float*)d_in[20]; a.moe_wu = (const float*)d_in[21]; a.moe_wd = (const float*)d_in[22];
    a.out = (float*)d_out; a.ws = (unsigned char*)d_ws;
    a.ph_lo = 0; a.ph_hi = NSTEPS;
    hipLaunchKernelGGL(fwd, dim3(grid), dim3(NWAVES * 64), LDS_BYTES, stream, a);
}
```
